# Optimizing an MI355X kernel written in HIP

```python
import math
import jax, jax.numpy as jnp
from jax import lax
import numpy as np

D_MODEL = 1024
BATCH = 8
SEQ = 2048
DEPTH = 2

CTX_LEN = 256
GRID_W = 64
MIX_WIDTH = D_MODEL

GLA_HEADS = 4
GLA_DV = MIX_WIDTH // 2 // GLA_HEADS
GLA_DK = GLA_DV // 2
GLA_RANK = 16
GLA_TAU = 16.0
GLA_CHUNK = 64
GLA_K_W = GLA_HEADS * GLA_DK
GLA_V_W = GLA_HEADS * GLA_DV

FOURIER_GROUPS = 4
FOURIER_WIDTH = MIX_WIDTH // 4

CONV_GROUPS = 4
CONV_WIDTH = MIX_WIDTH - GLA_V_W - FOURIER_WIDTH
CONV_K = 3

FFN_HIDDEN = -(-8 * D_MODEL // (3 * 256)) * 256
RMS_EPS = 1e-6
N_MOD = 6

STATE_COLS = GLA_K_W + GLA_V_W + 2 * GLA_RANK
IN_COLS = STATE_COLS + GLA_K_W + GLA_V_W + FOURIER_WIDTH + 3 * CONV_WIDTH
STATE_SPLITS = [GLA_K_W, GLA_K_W + GLA_V_W, GLA_K_W + GLA_V_W + GLA_RANK]
MAIN_SPLITS = [
    STATE_COLS,
    STATE_COLS + GLA_K_W,
    STATE_COLS + GLA_K_W + GLA_V_W,
    STATE_COLS + GLA_K_W + GLA_V_W + FOURIER_WIDTH,
    STATE_COLS + GLA_K_W + GLA_V_W + FOURIER_WIDTH + CONV_WIDTH,
    STATE_COLS + GLA_K_W + GLA_V_W + FOURIER_WIDTH + 2 * CONV_WIDTH,
]

kernel_name = "hybrid_gla_fourier_conv_dit_block"


def rmsnorm(x, g):
    xf = x.astype(jnp.float32)
    y = xf * lax.rsqrt(jnp.mean(xf * xf, axis=-1, keepdims=True) + RMS_EPS)
    return (y * g.astype(jnp.float32)).astype(x.dtype)


def modulate(h, shift, scale):
    return h * (1 + scale) + shift


def flip(t):
    return jnp.flip(t, axis=1)


def grid_pos_embed(n_tokens, dim, dtype):
    rows = n_tokens // GRID_W
    row = jnp.repeat(jnp.arange(rows, dtype=jnp.float32), GRID_W)
    col = jnp.tile(jnp.arange(GRID_W, dtype=jnp.float32), rows)
    quarter = dim // 4
    freqs = 1.0 / (10000.0 ** (jnp.arange(quarter, dtype=jnp.float32) / quarter))

    def enc(p):
        ang = p[:, None] * freqs[None, :]
        return jnp.concatenate([jnp.sin(ang), jnp.cos(ang)], axis=-1)

    return jnp.concatenate([enc(row), enc(col)], axis=-1).astype(dtype)


def gla_chunked(q, k, v, logg, s0, with_output=True):
    f32 = jnp.float32
    b, l, h, dk = k.shape
    dv = v.shape[-1]
    n = l // GLA_CHUNK
    k = k.astype(f32).reshape(b, n, GLA_CHUNK, h, dk)
    v = v.astype(f32).reshape(b, n, GLA_CHUNK, h, dv)
    g = jnp.cumsum(logg.astype(f32).reshape(b, n, GLA_CHUNK, h, dk), axis=2)
    g_last = g[:, :, -1]
    k_upd = k * jnp.exp(g_last[:, :, None] - g)
    ds = jnp.einsum('bnjhd,bnjhv->nbhdv', k_upd, v)
    decay = jnp.moveaxis(jnp.exp(g_last), 1, 0)

    def step(s, inp):
        dec, d = inp
        return dec[..., None] * s + d, s

    s_final, s_start = lax.scan(step, s0.astype(f32), (decay, ds))
    if not with_output:
        return None, s_final
    q = q.astype(f32).reshape(b, n, GLA_CHUNK, h, dk)
    g_mid = g[:, :, GLA_CHUNK // 2 - 1][:, :, None]
    scores = jnp.einsum('bnihd,bnjhd->bnhij', q * jnp.exp(g - g_mid), k * jnp.exp(g_mid - g))
    mask = jnp.tril(jnp.ones((GLA_CHUNK, GLA_CHUNK), dtype=bool))
    scores = jnp.where(mask, scores, 0.0)
    o_intra = jnp.einsum('bnhij,bnjhv->bnihv', scores, v)
    o_inter = jnp.einsum('bnihd,nbhdv->bnihv', q * jnp.exp(g), s_start)
    return (o_intra + o_inter).reshape(b, l, h, dv), s_final


def gla_state_inputs(p_state, w_dec_f, b_dec_f, w_dec_b, b_dec_b):
    k, v, lr_f, lr_b = jnp.split(p_state, STATE_SPLITS, axis=-1)
    b, l = k.shape[:2]
    k = k.reshape(b, l, GLA_HEADS, GLA_DK)
    v = v.reshape(b, l, GLA_HEADS, GLA_DV)
    logg_f = jax.nn.log_sigmoid((lr_f @ w_dec_f + b_dec_f).astype(jnp.float32)) / GLA_TAU
    logg_b = jax.nn.log_sigmoid((lr_b @ w_dec_b + b_dec_b).astype(jnp.float32)) / GLA_TAU
    return (k, v, logg_f.reshape(b, l, GLA_HEADS, GLA_DK), logg_b.reshape(b, l, GLA_HEADS, GLA_DK))


def zero_state(b):
    return jnp.zeros((b, GLA_HEADS, GLA_DK, GLA_DV), jnp.float32)


def fourier_mix(u):
    b, l, w = u.shape
    uf = u.astype(jnp.float32).reshape(b, l, FOURIER_GROUPS, w // FOURIER_GROUPS)
    y = jnp.fft.fft2(uf, axes=(1, 3), norm="ortho").real
    return y.reshape(b, l, w).astype(u.dtype)


def short_conv(b_gate, c_gate, u, conv_w, conv_b):
    z = c_gate * u
    zp = jnp.pad(z, ((0, 0), (1, 1), (0, 0)))
    y = conv_w[0] * zp[:, :-2] + conv_w[1] * zp[:, 1:-1] + conv_w[2] * zp[:, 2:] + conv_b
    return b_gate * y


def context_states(h, w_in, w_dec_f, b_dec_f, w_dec_b, b_dec_b):
    p_state = h @ w_in[:, :STATE_COLS]
    k, v, gf, gb = gla_state_inputs(p_state, w_dec_f, b_dec_f, w_dec_b, b_dec_b)
    s0 = zero_state(h.shape[0])
    _, s_f = gla_chunked(None, k, v, gf, s0, with_output=False)
    _, s_b = gla_chunked(None, flip(k), flip(v), flip(gb), s0, with_output=False)
    return s_f, s_b


def token_mixer(h, w_in, w_dec_f, b_dec_f, w_dec_b, b_dec_b, gla_norm_w, conv_w, conv_b, w_out, s_f0, s_b0):
    b, l, _ = h.shape
    p = h @ w_in
    p_state, q, r, u_four, b_gate, c_gate, u_conv = jnp.split(p, MAIN_SPLITS, axis=-1)
    k, v, gf, gb = gla_state_inputs(p_state, w_dec_f, b_dec_f, w_dec_b, b_dec_b)
    q = q.reshape(b, l, GLA_HEADS, GLA_DK) * (GLA_DK ** -0.5)
    o_f, s_f = gla_chunked(q, k, v, gf, s_f0)
    o_b, s_b = gla_chunked(flip(q), flip(k), flip(v), flip(gb), s_b0)
    o = o_f + flip(o_b)
    o = o * lax.rsqrt(jnp.mean(o * o, axis=-1, keepdims=True) + RMS_EPS)
    o = o * gla_norm_w.astype(jnp.float32).reshape(GLA_HEADS, GLA_DV)
    y_gla = o.reshape(b, l, GLA_V_W).astype(h.dtype) * jax.nn.silu(r)
    y_four = fourier_mix(u_four)
    y_conv = short_conv(b_gate, c_gate, u_conv, conv_w, conv_b)
    y = jnp.concatenate([y_gla, y_four, y_conv], axis=-1) @ w_out
    return y, s_f, s_b


def ffn_sublayer(x, shift, scale, gate, g_pre, g_post, w_ffn_in, w_ffn_out):
    h = modulate(rmsnorm(x, g_pre), shift, scale)
    a, u = jnp.split(h @ w_ffn_in, 2, axis=-1)
    y = (jax.nn.silu(a) * u) @ w_ffn_out
    return x + gate * rmsnorm(y, g_post)


def setup_inputs(seed: int = 0) -> dict:
    key = jax.random.key(seed)
    ks = jax.random.split(key, 24)
    f32 = jnp.float32
    D = D_MODEL

    def nrm(k, shape, scale):
        return jax.random.normal(k, shape, f32) * scale

    def gain(k, shape):
        return 1.0 + 0.05 * jax.random.normal(k, shape, f32)

    return {
        "x": nrm(ks[0], (BATCH, SEQ, D), 1.0),
        "c": nrm(ks[1], (BATCH, D), 1.0),
        "ctx": nrm(ks[2], (BATCH, CTX_LEN, D), 1.0),
        "c_ctx": nrm(ks[3], (D,), 1.0),
        "w_mod": nrm(ks[4], (DEPTH, D, N_MOD * D), 0.5 * D ** -0.5),
        "b_mod": nrm(ks[5], (DEPTH, N_MOD * D), 0.02),
        "g_mix_pre": gain(ks[6], (DEPTH, D)),
        "g_mix_post": gain(ks[7], (DEPTH, D)),
        "g_ffn_pre": gain(ks[8], (DEPTH, D)),
        "g_ffn_post": gain(ks[9], (DEPTH, D)),
        "w_in": nrm(ks[10], (DEPTH, D, IN_COLS), D ** -0.5),
        "w_dec_f": nrm(ks[11], (DEPTH, GLA_RANK, GLA_K_W), GLA_RANK ** -0.5),
        "b_dec_f": nrm(ks[12], (DEPTH, GLA_K_W), 0.1),
        "w_dec_b": nrm(ks[13], (DEPTH, GLA_RANK, GLA_K_W), GLA_RANK ** -0.5),
        "b_dec_b": nrm(ks[14], (DEPTH, GLA_K_W), 0.1),
        "gla_norm_w": gain(ks[15], (DEPTH, GLA_V_W)),
        "conv_w": nrm(ks[16], (DEPTH, CONV_K, CONV_WIDTH), CONV_K ** -0.5),
        "conv_b": nrm(ks[17], (DEPTH, CONV_WIDTH), 0.02),
        "w_out": nrm(ks[18], (DEPTH, MIX_WIDTH, D), MIX_WIDTH ** -0.5),
        "w_ffn_in": nrm(ks[19], (DEPTH, D, 2 * FFN_HIDDEN), D ** -0.5),
        "w_ffn_out": nrm(ks[20], (DEPTH, FFN_HIDDEN, D), FFN_HIDDEN ** -0.5),
    }


def reference(x, c, ctx, c_ctx, w_mod, b_mod, g_mix_pre, g_mix_post, g_ffn_pre, g_ffn_post,
              w_in, w_dec_f, b_dec_f, w_dec_b, b_dec_b, gla_norm_w, conv_w, conv_b, w_out,
              w_ffn_in, w_ffn_out):
    n_lat = x.shape[1]
    x = x + grid_pos_embed(n_lat, x.shape[-1], x.dtype)[None]
    xc = ctx
    for i in range(DEPTH):
        last = i == DEPTH - 1
        mod_lat = jnp.split((jax.nn.silu(c) @ w_mod[i] + b_mod[i])[:, None, :], N_MOD, axis=-1)
        mod_ctx = jnp.split((jax.nn.silu(c_ctx) @ w_mod[i] + b_mod[i])[None, None, :], N_MOD, axis=-1)
        mix_w = (w_in[i], w_dec_f[i], b_dec_f[i], w_dec_b[i], b_dec_b[i], gla_norm_w[i], conv_w[i], conv_b[i], w_out[i])

        h_lat = modulate(rmsnorm(x, g_mix_pre[i]), mod_lat[0], mod_lat[1])
        h_ctx = modulate(rmsnorm(xc, g_mix_pre[i]), mod_ctx[0], mod_ctx[1])
        if last:
            s_f, s_b = context_states(h_ctx, w_in[i], w_dec_f[i], b_dec_f[i], w_dec_b[i], b_dec_b[i])
        else:
            s0 = zero_state(xc.shape[0])
            y_ctx, s_f, s_b = token_mixer(h_ctx, *mix_w, s0, s0)
            xc = xc + mod_ctx[2] * rmsnorm(y_ctx, g_mix_post[i])
            xc = ffn_sublayer(xc, mod_ctx[3], mod_ctx[4], mod_ctx[5], g_ffn_pre[i], g_ffn_post[i], w_ffn_in[i], w_ffn_out[i])

        y_lat, _, _ = token_mixer(h_lat, *mix_w, s_f, s_b)
        x = x + mod_lat[2] * rmsnorm(y_lat, g_mix_post[i])
        x = ffn_sublayer(x, mod_lat[3], mod_lat[4], mod_lat[5], g_ffn_pre[i], g_ffn_post[i], w_ffn_in[i], w_ffn_out[i])
    return x
```

```cpp
#include <hip/hip_runtime.h>
#include <hip/hip_cooperative_groups.h>
#include <cstdio>
#include <cstdint>
namespace cg = cooperative_groups;
namespace pg8 {
#define PG8_LAS __attribute__((address_space(3)))
typedef unsigned short bf16_t;
typedef short bf16x8 __attribute__((ext_vector_type(8)));
typedef float f32x4 __attribute__((ext_vector_type(4)));
typedef unsigned u32x4 __attribute__((ext_vector_type(4)));
constexpr int BM = 256, BK = 64, HALF = 128, HTB = HALF * BK * 2  , STAGE_BYTES = 8 * HTB, NXCD = 8, WGM = 8;

__host__ __device__ __forceinline__ int lds_byte(int r, int c) { const int st = (r >> 4) * 2 + (c >> 5), rr = r & 15, cc = c & 31, ob = rr * 64 + cc * 2; return st * 1024 + (ob ^ (((ob >> 9) & 1) << 5)); }
__host__ __device__ __forceinline__ void stage_rc(int b, int& R, int& C) { const int st = b / 1024, sb = b % 1024, swz = sb ^ (((sb >> 9) & 1) << 5); R = (st >> 1) * 16 + swz / 64; C = (st & 1) * 32 + (swz % 64) / 2; }
__host__ __device__ __forceinline__ int perm32(int rho) { const int n = rho >> 4, i = rho & 15; return 8 * (i >> 2) + 4 * n + (i & 3); }

struct Unit { int pm, pn; };
struct Gemm { const bf16_t* A; const bf16_t* Bt; int M, N, K; };

struct StaticOrder {
    int nM, nN, nwg, G, c;
    __host__ __device__ void init(int M, int N, int G_, int c_) { nM = M / BM; nN = N / BM; nwg = nM * nN; G = G_; c = c_; }
    __host__ __device__ bool next(int i, Unit& u) const {
        const long L = (long)i * G + c; if (L >= nwg) return false;
        int wgid = (int)L; { const int q = nwg / NXCD, r = nwg % NXCD, xcd = wgid % NXCD, off = wgid / NXCD; wgid = (xcd < r ? xcd * (q + 1) : r * (q + 1) + (xcd - r) * q) + off; }
        const int nig = WGM * nN, gid = wgid / nig, fm = gid * WGM, gsz = (nM - fm) < WGM ? (nM - fm) : WGM;
        u.pm = fm + ((wgid % nig) % gsz); u.pn = (wgid % nig) / gsz; return true;
    }
    __device__ __forceinline__ void a_ready(const Unit&) const {}
    __device__ __forceinline__ void done(const Unit&) const {}
};

__device__ __forceinline__ unsigned cvt_pk_bf16(float lo, float hi) { unsigned r; asm volatile("v_cvt_pk_bf16_f32 %0, %1, %2" : "=v"(r) : "v"(lo), "v"(hi)); return r; }
template <class Epi, class Sched, bool ALIGN_EPI = false, bool SP2 = false>
__device__ __forceinline__ void gemm_phase(PG8_LAS unsigned char* lds, const Gemm g, const Sched& S, const Epi& E) {
    int tid_ = threadIdx.x; asm volatile("" : "+v"(tid_));
    const int tid = tid_, wid = __builtin_amdgcn_readfirstlane(tid >> 6), lane = tid & 63, wr = wid >> 2, wc = wid & 3, fr = lane & 15, fq = lane >> 4;
    const int K = g.K, nt = K / BK;
    unsigned voffA[2], voffB[2];
#pragma unroll
    for (int i = 0; i < 2; ++i) { int R, C; stage_rc(tid * 16 + i * 8192, R, C); const int Rb = Epi::PERM ? ((R & ~31) + perm32(R & 31)) : R;
        voffA[i] = (unsigned)(R * K + C) * 2u; voffB[i] = (unsigned)(Rb * K + C) * 2u; }
    const size_t kstep = (size_t)(BK * 2);
    const size_t hstep = (size_t)HALF * K * 2;
    const size_t tstep = 2 * hstep;
    const unsigned ldsw = (unsigned)wid * 1024u;
    const int aoff = lds_byte(wr * 64 + fr, fq * 8), boff = lds_byte(wc * 32 + fr, fq * 8);
#define PG8_SA(b, h) (((b) * 2 + (h)) * HTB)
#define PG8_SB(b, h) ((4 + (b) * 2 + (h)) * HTB)
#define PG8_STAGE(bufoff, gbase, voff) do { _Pragma("unroll") for (int _i = 0; _i < 2; ++_i) \
        __builtin_amdgcn_global_load_lds((const unsigned*)((const char*)(gbase) + (voff)[_i]), (PG8_LAS unsigned*)(lds + (bufoff) + ldsw + _i * 8192), 16, 0, 0); } while (0)
#define PG8_LDA(dst, b, h) do { _Pragma("unroll") for (int m = 0; m < 4; ++m) _Pragma("unroll") for (int k = 0; k < 2; ++k) dst[m][k] = *(const PG8_LAS bf16x8*)(lds + PG8_SA(b, h) + aoff + m * 2048 + k * 1024); } while (0)
#define PG8_LDB(dst, b, h) do { _Pragma("unroll") for (int n = 0; n < 2; ++n) _Pragma("unroll") for (int k = 0; k < 2; ++k) dst[n][k] = *(const PG8_LAS bf16x8*)(lds + PG8_SB(b, h) + boff + n * 2048 + k * 1024); } while (0)
#define PG8_MMA(ai, bj, At, Bt) do { __builtin_amdgcn_s_setprio(1); _Pragma("unroll") for (int m = 0; m < 4; ++m) _Pragma("unroll") for (int n = 0; n < 2; ++n) _Pragma("unroll") for (int k = 0; k < 2; ++k) \
        acc[ai][bj][m][n] = __builtin_amdgcn_mfma_f32_16x16x32_bf16(Bt[n][k], At[m][k], acc[ai][bj][m][n], 0, 0, 0); __builtin_amdgcn_s_setprio(0); } while (0)
#define PG8_WAIT_V(n) asm volatile("s_waitcnt vmcnt(" #n ")" ::: "memory")
#define PG8_WAIT_L(n) asm volatile("s_waitcnt lgkmcnt(" #n ")" ::: "memory")
#define PG8_BAR __builtin_amdgcn_s_barrier()
#define PG8_SCHED __builtin_amdgcn_sched_barrier(0)
    Unit cur, nxt; int ui = 0;
    if (!S.next(0, cur)) return;
    f32x4 acc[2][2][4][2];
#pragma unroll
    for (int a = 0; a < 2; ++a)
#pragma unroll
        for (int b = 0; b < 2; ++b)
#pragma unroll
            for (int m = 0; m < 4; ++m)
#pragma unroll
                for (int n = 0; n < 2; ++n) acc[a][b][m][n] = (f32x4){0.f, 0.f, 0.f, 0.f};
    bf16x8 At[4][2], B0[2][2], B1[2][2];
    const char* cA = (const char*)g.A + (size_t)cur.pm * tstep; const char* cB = (const char*)g.Bt + (size_t)cur.pn * tstep;
    S.a_ready(cur);
    if constexpr (SP2) {
        PG8_STAGE(PG8_SB(0, 0), cB, voffB); PG8_STAGE(PG8_SB(0, 1), cB + hstep, voffB); PG8_STAGE(PG8_SA(0, 0), cA, voffA); PG8_STAGE(PG8_SA(0, 1), cA + hstep, voffA);
        if (wr == 1) PG8_BAR;
        PG8_WAIT_V(2); PG8_BAR;
        PG8_STAGE(PG8_SB(1, 0), cB + kstep, voffB); PG8_STAGE(PG8_SA(1, 0), cA + kstep, voffA); PG8_STAGE(PG8_SB(1, 1), cB + hstep + kstep, voffB);
        PG8_WAIT_V(6); PG8_BAR;
    } else {
        PG8_STAGE(PG8_SB(0, 0), cB, voffB); PG8_STAGE(PG8_SA(0, 0), cA, voffA); PG8_STAGE(PG8_SB(0, 1), cB + hstep, voffB); PG8_STAGE(PG8_SA(0, 1), cA + hstep, voffA);
        if (wr == 1) PG8_BAR;
        PG8_WAIT_V(4); PG8_BAR;
        PG8_STAGE(PG8_SB(1, 0), cB + kstep, voffB); PG8_STAGE(PG8_SA(1, 0), cA + kstep, voffA); PG8_STAGE(PG8_SB(1, 1), cB + hstep + kstep, voffB);
        PG8_WAIT_V(6); PG8_BAR;
    }
    for (;;) {
        const bool has_next = S.next(ui + 1, nxt);
        const char* nA = has_next ? (const char*)g.A + (size_t)nxt.pm * tstep : cA; const char* nB = has_next ? (const char*)g.Bt + (size_t)nxt.pn * tstep : cB;
        for (int t = 0; t < nt; t += 2) {
            const bool last = (t == nt - 2);
            const char* a1 = cA + (size_t)(t + 1) * kstep;
            const char* a2 = last ? nA : cA + (size_t)(t + 2) * kstep; const char* b2 = last ? nB : cB + (size_t)(t + 2) * kstep;
            const char* a3 = a2 + kstep; const char* b3 = b2 + kstep;
            if (last && has_next) S.a_ready(nxt);
            if constexpr (SP2) {
            PG8_LDB(B0, 0, 0); PG8_LDB(B1, 0, 1); PG8_SCHED; PG8_LDA(At, 0, 0); PG8_STAGE(PG8_SA(1, 1), a1 + hstep, voffA);
            PG8_WAIT_V(8); PG8_WAIT_L(0); PG8_BAR; PG8_MMA(0, 0, At, B0); PG8_MMA(0, 1, At, B1); PG8_BAR; PG8_SCHED;
            PG8_LDA(At, 0, 1); PG8_STAGE(PG8_SB(0, 0), b2, voffB); PG8_STAGE(PG8_SB(0, 1), b2 + hstep, voffB); PG8_STAGE(PG8_SA(0, 0), a2, voffA);
            PG8_WAIT_V(8); PG8_WAIT_L(0); PG8_BAR; PG8_MMA(1, 0, At, B0); PG8_MMA(1, 1, At, B1); PG8_BAR; PG8_SCHED;
            PG8_LDB(B0, 1, 0); PG8_LDB(B1, 1, 1); PG8_SCHED; PG8_LDA(At, 1, 0); PG8_STAGE(PG8_SA(0, 1), a2 + hstep, voffA);
            PG8_WAIT_V(8); PG8_WAIT_L(0); PG8_BAR; PG8_MMA(0, 0, At, B0); PG8_MMA(0, 1, At, B1); PG8_BAR; PG8_SCHED;
            PG8_LDA(At, 1, 1); PG8_STAGE(PG8_SB(1, 0), b3, voffB); PG8_STAGE(PG8_SB(1, 1), b3 + hstep, voffB); PG8_STAGE(PG8_SA(1, 0), a3, voffA);
            PG8_WAIT_V(8); PG8_WAIT_L(0); PG8_BAR; PG8_MMA(1, 0, At, B0); PG8_MMA(1, 1, At, B1); PG8_BAR; PG8_SCHED;
            } else {
            PG8_LDB(B0, 0, 0); PG8_SCHED; PG8_LDA(At, 0, 0); PG8_STAGE(PG8_SA(1, 1), a1 + hstep, voffA);
            PG8_WAIT_L(8); PG8_BAR; PG8_WAIT_L(0); PG8_MMA(0, 0, At, B0); PG8_BAR; PG8_SCHED;
            PG8_LDB(B1, 0, 1); PG8_STAGE(PG8_SB(0, 0), b2, voffB);
            PG8_BAR; PG8_WAIT_L(0); PG8_MMA(0, 1, At, B1); PG8_BAR;
            PG8_LDA(At, 0, 1); PG8_STAGE(PG8_SA(0, 0), a2, voffA);
            PG8_BAR; PG8_WAIT_L(0); PG8_MMA(1, 0, At, B0); PG8_BAR; PG8_SCHED;
            PG8_STAGE(PG8_SB(0, 1), b2 + hstep, voffB);
            PG8_WAIT_V(6); PG8_BAR; PG8_MMA(1, 1, At, B1); PG8_BAR;
            PG8_LDB(B0, 1, 0); PG8_SCHED; PG8_LDA(At, 1, 0); PG8_STAGE(PG8_SA(0, 1), a2 + hstep, voffA);
            PG8_WAIT_L(8); PG8_BAR; PG8_WAIT_L(0); PG8_MMA(0, 0, At, B0); PG8_BAR; PG8_SCHED;
            PG8_LDB(B1, 1, 1); PG8_STAGE(PG8_SB(1, 0), b3, voffB);
            PG8_BAR; PG8_WAIT_L(0); PG8_MMA(0, 1, At, B1); PG8_BAR;
            PG8_LDA(At, 1, 1); PG8_STAGE(PG8_SA(1, 0), a3, voffA);
            PG8_BAR; PG8_WAIT_L(0); PG8_MMA(1, 0, At, B0); PG8_BAR; PG8_SCHED;
            PG8_STAGE(PG8_SB(1, 1), b3 + hstep, voffB);
            PG8_WAIT_V(6); PG8_BAR; PG8_MMA(1, 1, At, B1); PG8_BAR;
            }
        }
        if constexpr (ALIGN_EPI) { if (wr == 0) PG8_BAR; }
        if constexpr (!Epi::AFTER_DRAIN) { E(acc, cur, wr, wc, fr, fq); S.done(cur); }
        if (!has_next) break;
#pragma unroll
        for (int a = 0; a < 2; ++a)
#pragma unroll
            for (int b = 0; b < 2; ++b)
#pragma unroll
                for (int m = 0; m < 4; ++m)
#pragma unroll
                    for (int n = 0; n < 2; ++n) acc[a][b][m][n] = (f32x4){0.f, 0.f, 0.f, 0.f};
        cur = nxt; cA = nA; cB = nB; ++ui;
        if constexpr (ALIGN_EPI) { if (wr == 1) PG8_BAR; }
    }
    PG8_WAIT_V(0);
    if constexpr (!ALIGN_EPI) { if (wr == 0) PG8_BAR; }
    PG8_BAR;
    if constexpr (Epi::AFTER_DRAIN) { E.fused(acc, cur, wr, wc, fr, fq, lds, wid, lane); S.done(cur); }
#undef PG8_SA
#undef PG8_SB
#undef PG8_STAGE
#undef PG8_LDA
#undef PG8_LDB
#undef PG8_MMA
#undef PG8_WAIT_V
#undef PG8_WAIT_L
#undef PG8_BAR
#undef PG8_SCHED
}
}

#define LAS __attribute__((address_space(3)))
typedef unsigned short bf16_t;
typedef short bf16x8 __attribute__((ext_vector_type(8)));
typedef float f32x4 __attribute__((ext_vector_type(4)));
typedef float f32x2 __attribute__((ext_vector_type(2)));
typedef unsigned u32x4 __attribute__((ext_vector_type(4)));
typedef unsigned u32x2 __attribute__((ext_vector_type(2)));

constexpr int D = 1024, NB = 8, SEQ = 2048, CTXL = 256, MLAT = NB * SEQ, MCTX = NB * CTXL, MTOT = MLAT + MCTX;
constexpr int INC = 2592, NP = 2560, NPA = 1536, NPB = 1024, FFH = 2816;
constexpr int NCH = 36;
constexpr int NTHR = 512;
constexpr float EPS = 1e-6f;
constexpr int LDS_BYTES = 147456;

constexpr size_t MiB = 1u << 20;
constexpr size_t WS_WIN = 1 * MiB;
constexpr size_t WS_WOUT = 11 * MiB;
constexpr size_t WS_WFI = 15 * MiB;
constexpr size_t WS_WFO = 37 * MiB;
constexpr size_t WS_MOD = 48 * MiB;
constexpr size_t WS_PE = WS_MOD + 512 * 1024;
constexpr size_t WS_WLR = WS_PE + 128 * 1024;
constexpr size_t WS_DEC = WS_WLR + 256 * 1024;
constexpr size_t WS_DL = 50 * MiB;
constexpr size_t WS_DLC = 58 * MiB;
constexpr size_t WS_XC = 59 * MiB;
constexpr size_t WS_LR = 67 * MiB;
constexpr size_t WS_H = 70 * MiB;
constexpr size_t WS_PA = 106 * MiB;
constexpr size_t WS_PB = 160 * MiB;
constexpr size_t WS_YC = 196 * MiB;
constexpr size_t WS_ZT = 232 * MiB;
constexpr size_t WS_ZTC = 240 * MiB;
constexpr size_t WS_HID = 106 * MiB;
constexpr size_t WS_Y = 106 * MiB;
constexpr size_t WS_Y2 = 205 * MiB;
constexpr size_t WS_END = 241 * MiB;

struct Params { const float* in[21]; float* out; unsigned char* ws; };
typedef __attribute__((address_space(4))) const unsigned char kchar;
__device__ __forceinline__ kchar* kargs() { kchar* ka = (kchar*)__builtin_amdgcn_kernarg_segment_ptr(); asm volatile("" : "+s"(ka)); return ka; }
__device__ __forceinline__ const float* inp(int i) { return *(const float* __attribute__((address_space(4))) const*)(kargs() + 8 * i); }
__device__ __forceinline__ float* outp() { return *(float* __attribute__((address_space(4))) const*)(kargs() + 8 * 21); }
__device__ __forceinline__ unsigned char* wsp() { return *(unsigned char* __attribute__((address_space(4))) const*)(kargs() + 8 * 22); }

__device__ __forceinline__ float bf2f(unsigned short b) { return __uint_as_float(((unsigned)b) << 16); }
typedef __bf16 bf16x2_t __attribute__((ext_vector_type(2)));
__device__ __forceinline__ unsigned pkbf(float lo, float hi) { f32x2 v; v[0] = lo; v[1] = hi; const bf16x2_t b = __builtin_convertvector(v, bf16x2_t); return __builtin_bit_cast(unsigned, b); }
__device__ __forceinline__ unsigned short f2bf(float f) { return (unsigned short)(pkbf(f, 0.f) & 0xffffu); }
__device__ __forceinline__ float lo16(unsigned r) { return __uint_as_float(r << 16); }
__device__ __forceinline__ float hi16(unsigned r) { return __uint_as_float(r & 0xffff0000u); }
__device__ __forceinline__ float wave_sum(float v) {
#pragma unroll
    for (int o = 1; o < 64; o <<= 1) v += __shfl_xor(v, o);
    return v;
}
__device__ __forceinline__ float silu_f(float a) { return a / (1.f + __expf(-a)); }
__device__ __forceinline__ float logsig16(float z) { return (fminf(z, 0.f) - log1pf(expf(-fabsf(z)))) * (1.f / 16.f); }

struct EpiStore {
    static constexpr bool PERM = true, AFTER_DRAIN = false;
    bf16_t* O0; int ld0; bf16_t* O1; int ld1; int split;
    __device__ __forceinline__ void operator()(const pg8::f32x4 (&acc)[2][2][4][2], const pg8::Unit& u, int wr, int wc, int fr, int fq) const {
        const int row0 = u.pm * 256 + wr * 64 + fr;
        bf16_t* base; int ld, colt;
        if (u.pn < split) { base = O0; ld = ld0; colt = u.pn * 256; } else { base = O1; ld = ld1; colt = (u.pn - split) * 256; }
        const int col0 = colt + wc * 32 + 8 * fq;
#pragma unroll
        for (int ai = 0; ai < 2; ++ai)
#pragma unroll
            for (int m = 0; m < 4; ++m) { bf16_t* rowp = base + (size_t)(row0 + ai * 128 + m * 16) * ld + col0;
#pragma unroll
                for (int bj = 0; bj < 2; ++bj) { const pg8::f32x4 v0 = acc[ai][bj][m][0], v1 = acc[ai][bj][m][1];
                    u32x4 w; w.x = pkbf(v0[0], v0[1]); w.y = pkbf(v0[2], v0[3]); w.z = pkbf(v1[0], v1[1]); w.w = pkbf(v1[2], v1[3]);
                    *(u32x4*)(rowp + bj * 128) = w; } }
    }
};
struct EpiF2 {
    static constexpr bool PERM = true, AFTER_DRAIN = false;
    bf16_t* O; int L;
    __device__ __forceinline__ void operator()(const pg8::f32x4 (&acc)[2][2][4][2], const pg8::Unit& u, int wr, int wc, int fr, int fq) const {
        const int row0 = u.pn * L + u.pm * 256 + wr * 64 + fr;
        const int col0 = wc * 32 + 8 * fq;
#pragma unroll
        for (int ai = 0; ai < 2; ++ai)
#pragma unroll
            for (int m = 0; m < 4; ++m) { bf16_t* rowp = O + (size_t)(row0 + ai * 128 + m * 16) * D + col0;
#pragma unroll
                for (int bj = 0; bj < 2; ++bj) { const pg8::f32x4 v0 = acc[ai][bj][m][0], v1 = acc[ai][bj][m][1];
                    u32x4 w; w.x = pkbf(v0[0], v0[1]); w.y = pkbf(v0[2], v0[3]); w.z = pkbf(v1[0], v1[1]); w.w = pkbf(v1[2], v1[3]);
                    *(u32x4*)(rowp + bj * 128) = w; } }
    }
};
struct EpiSwiglu {
    static constexpr bool PERM = true, AFTER_DRAIN = false;
    bf16_t* O; int ld;
    __device__ __forceinline__ void operator()(const pg8::f32x4 (&acc)[2][2][4][2], const pg8::Unit& u, int wr, int wc, int fr, int fq) const {
        const int row0 = u.pm * 256 + wr * 64 + fr;
        const int col0 = u.pn * 128 + wc * 32 + 8 * fq;
#pragma unroll
        for (int ai = 0; ai < 2; ++ai)
#pragma unroll
            for (int m = 0; m < 4; ++m) { bf16_t* rowp = O + (size_t)(row0 + ai * 128 + m * 16) * ld + col0;
                const pg8::f32x4 a0 = acc[ai][0][m][0], a1 = acc[ai][0][m][1], u0 = acc[ai][1][m][0], u1 = acc[ai][1][m][1];
                u32x4 w;
                w.x = pkbf(silu_f(a0[0]) * u0[0], silu_f(a0[1]) * u0[1]); w.y = pkbf(silu_f(a0[2]) * u0[2], silu_f(a0[3]) * u0[3]);
                w.z = pkbf(silu_f(a1[0]) * u1[0], silu_f(a1[1]) * u1[1]); w.w = pkbf(silu_f(a1[2]) * u1[2], silu_f(a1[3]) * u1[3]);
                *(u32x4*)rowp = w; }
    }
};

__device__ __forceinline__ void transpose_item(const float* W, int K, int N, int k0, int n0, bf16_t* WT, int dst_row0, LAS float* scr, int lane) {
#pragma unroll 8
    for (int i = 0; i < 32; ++i) { const int kk = 2 * i + (lane >> 5); scr[kk * 33 + (lane & 31)] = W[(size_t)(k0 + kk) * N + n0 + (lane & 31)]; }
    asm volatile("s_waitcnt lgkmcnt(0)" ::: "memory");
    const int c = lane & 7;
#pragma unroll
    for (int j = 0; j < 4; ++j) { const int n = (lane >> 3) + 8 * j; const LAS float* s = scr + (8 * c) * 33 + n;
        u32x4 o; o.x = pkbf(s[0 * 33], s[1 * 33]); o.y = pkbf(s[2 * 33], s[3 * 33]); o.z = pkbf(s[4 * 33], s[5 * 33]); o.w = pkbf(s[6 * 33], s[7 * 33]);
        *(u32x4*)(WT + (size_t)(dst_row0 + n) * K + k0 + 8 * c) = o; }
    asm volatile("s_waitcnt lgkmcnt(0)" ::: "memory");
}

__device__ __forceinline__ void phase_prologue(const Params& p, LAS unsigned char* lds, int tid, int lane, int wave, int bid, int G) {
    unsigned char* ws = wsp();
    {
        LAS float* sc = (LAS float*)lds;
        LAS float* red = (LAS float*)(lds + 36864);
        float* MOD = (float*)(ws + WS_MOD);
        for (int it = bid; it < 48; it += G) {
            const int li = it / 24, jb = it % 24;
            for (int e = tid; e < 9 * 1024; e += NTHR) { const int r = e >> 10, k = e & 1023; const float cv = r < 8 ? inp(1)[r * 1024 + k] : inp(3)[k]; sc[e] = cv / (1.f + expf(-cv)); }
            __syncthreads();
            float acc[9][4];
#pragma unroll
            for (int r = 0; r < 9; ++r) { acc[r][0] = 0.f; acc[r][1] = 0.f; acc[r][2] = 0.f; acc[r][3] = 0.f; }
            const float* wm = inp(4) + ((size_t)li * 1024 + wave * 128) * 6144 + jb * 256 + lane * 4;
#pragma unroll 4
            for (int k = 0; k < 128; ++k) { const f32x4 wv = *(const f32x4*)(wm + (size_t)k * 6144);
#pragma unroll
                for (int r = 0; r < 9; ++r) { const float s = sc[r * 1024 + wave * 128 + k]; acc[r][0] += s * wv[0]; acc[r][1] += s * wv[1]; acc[r][2] += s * wv[2]; acc[r][3] += s * wv[3]; } }
#pragma unroll
            for (int r = 0; r < 9; ++r) { f32x4 o; o[0] = acc[r][0]; o[1] = acc[r][1]; o[2] = acc[r][2]; o[3] = acc[r][3]; *(LAS f32x4*)(red + ((wave * 9 + r) * 256 + lane * 4)) = o; }
            __syncthreads();
            for (int e = tid; e < 9 * 256; e += NTHR) { const int r = e >> 8, jj = e & 255; float s = inp(5)[li * 6144 + jb * 256 + jj];
#pragma unroll
                for (int w = 0; w < 8; ++w) s += red[(w * 9 + r) * 256 + jj];
                MOD[(size_t)(li * 9 + r) * 6144 + jb * 256 + jj] = s; }
            __syncthreads();
        }
    }
    {
        LAS float* scr = (LAS float*)(lds + wave * 16384);
        const int gw = bid * 8 + wave, NGW = G * 8;
        constexpr int I_IN = 16 * 81, I_OUT = 16 * 32, I_FI = 16 * 176, I_FO = 44 * 32, I_L = I_IN + I_OUT + I_FI + I_FO;
        bf16_t* Win_t = (bf16_t*)(ws + WS_WIN); bf16_t* Wout_t = (bf16_t*)(ws + WS_WOUT); bf16_t* Wfi_t = (bf16_t*)(ws + WS_WFI); bf16_t* Wfo_t = (bf16_t*)(ws + WS_WFO);
        float* WLR = (float*)(ws + WS_WLR);
        for (int it = gw; it < 2 * I_L; it += NGW) {
            const int li = it / I_L; int r = it % I_L;
            if (r < I_IN) { const int kb = r / 81, nb = r % 81, n0 = nb * 32, k0 = kb * 64; const float* W = inp(10) + (size_t)li * 1024 * INC;
                if (n0 == 768) {
#pragma unroll 8
                    for (int i = 0; i < 32; ++i) { const int kk = 2 * i + (lane >> 5); WLR[(size_t)(li * 1024 + k0 + kk) * 32 + (lane & 31)] = W[(size_t)(k0 + kk) * INC + 768 + (lane & 31)]; }
                } else transpose_item(W, 1024, INC, k0, n0, Win_t + (size_t)li * NP * 1024, n0 < 768 ? n0 : n0 - 32, scr, lane);
                continue; }
            r -= I_IN;
            if (r < I_OUT) { const int kb = r / 32, nb = r % 32; transpose_item(inp(18) + (size_t)li * 1024 * 1024, 1024, 1024, kb * 64, nb * 32, Wout_t + (size_t)li * 1024 * 1024, nb * 32, scr, lane); continue; }
            r -= I_OUT;
            if (r < I_FI) { const int kb = r / 176, nb = r % 176, n0 = nb * 32; const int j0 = n0 < FFH ? n0 : n0 - FFH; const int dst = 256 * (j0 / 128) + (j0 % 128) + (n0 < FFH ? 0 : 128);
                transpose_item(inp(19) + (size_t)li * 1024 * 2 * FFH, 1024, 2 * FFH, kb * 64, n0, Wfi_t + (size_t)li * 2 * FFH * 1024, dst, scr, lane); continue; }
            r -= I_FI;
            { const int kb = r / 32, nb = r % 32; transpose_item(inp(20) + (size_t)li * FFH * 1024, FFH, 1024, kb * 64, nb * 32, Wfo_t + (size_t)li * 1024 * FFH, nb * 32, scr, lane); }
        }
    }
    {
        const int gt = bid * NTHR + tid, NT = G * NTHR;
        float* PE = (float*)(ws + WS_PE);
        for (int e = gt; e < 64 * 512; e += NT) { const int pp = e >> 9, dd = e & 511, i = dd & 255; const float f = 1.0f / powf(10000.0f, (float)i / 256.0f); const float ang = (float)pp * f; PE[e] = dd < 256 ? sinf(ang) : cosf(ang); }
        bf16_t* DL = (bf16_t*)(ws + WS_DL);
        const float sL = 0.022097086912079608f;
        for (int it = gt; it < 2048 * 256; it += NT) { const int lp = it >> 8, k8 = (it & 255) * 8; float v[8];
#pragma unroll
            for (int j = 0; j < 8; ++j) { const int k = k8 + j; v[j] = (k <= 1024) ? cospif((float)((lp * k) & 2047) * (1.0f / 1024.0f)) * sL : -sinpif((float)((lp * (k - 1024)) & 2047) * (1.0f / 1024.0f)) * sL; }
            u32x4 o; o.x = pkbf(v[0], v[1]); o.y = pkbf(v[2], v[3]); o.z = pkbf(v[4], v[5]); o.w = pkbf(v[6], v[7]); *(u32x4*)(DL + (size_t)lp * 2048 + k8) = o; }
        bf16_t* DLC = (bf16_t*)(ws + WS_DLC);
        for (int it = gt; it < 256 * 32; it += NT) { const int lp = it >> 5, k8 = (it & 31) * 8; float v[8];
#pragma unroll
            for (int j = 0; j < 8; ++j) { const int k = k8 + j; v[j] = (k <= 128) ? cospif((float)((lp * k) & 255) * (1.0f / 128.0f)) * 0.0625f : -sinpif((float)((lp * (k - 128)) & 255) * (1.0f / 128.0f)) * 0.0625f; }
            u32x4 o; o.x = pkbf(v[0], v[1]); o.y = pkbf(v[2], v[3]); o.z = pkbf(v[4], v[5]); o.w = pkbf(v[6], v[7]); *(u32x4*)(DLC + (size_t)lp * 256 + k8) = o; }
    }
}

__device__ __forceinline__ void phase_rows(const Params& p, LAS unsigned char* lds, int tid, int lane, int wave, int bid, int G, int kind, int li) {
    unsigned char* ws = wsp();
    const bool need_h = !(kind == 2 && li == 1);
    const bool need_lr = need_h && kind != 1;
    const int lh = (kind == 1) ? li : (kind == 0 ? 0 : li + 1);
    const int nrows = (li == 1 && kind >= 1) ? MLAT : MTOT;
    LAS float* wl = (LAS float*)lds;
    const float* MOD = (const float*)(ws + WS_MOD);
    const float* PE = (const float*)(ws + WS_PE);
    float* XC = (float*)(ws + WS_XC);
    bf16_t* H = (bf16_t*)(ws + WS_H);
    float* LR = (float*)(ws + WS_LR);
    if (need_lr) {
        const float* WLR = (const float*)(ws + WS_WLR) + (size_t)lh * 1024 * 32;
        for (int e = tid; e < 32768; e += NTHR) { const int k = e >> 5, c = e & 31; wl[(k >> 1) * 68 + 2 * c + (k & 1)] = WLR[e]; }
        __syncthreads();
    }
    for (int r = bid * 8 + wave; r < nrows; r += G * 8) {
        const bool lat = r < MLAT;
        const int bidx = lat ? (r >> 11) : 8;
        const float* xin = (kind == 0) ? (lat ? inp(0) + (size_t)r * D : inp(2) + (size_t)(r - MLAT) * D) : (lat ? outp() + (size_t)r * D : XC + (size_t)(r - MLAT) * D);
        float* xout = lat ? outp() + (size_t)r * D : XC + (size_t)(r - MLAT) * D;
        float v[16];
#pragma unroll
        for (int j = 0; j < 8; ++j) { const f32x2 t2 = *(const f32x2*)(xin + 2 * lane + 128 * j); v[2 * j] = t2[0]; v[2 * j + 1] = t2[1]; }
        if (kind == 0 && lat) {
            const int t = r & 2047; const float* pa = PE + (t >> 6) * 512; const float* pb = PE + (t & 63) * 512;
#pragma unroll
            for (int j = 0; j < 8; ++j) { const int k = 2 * lane + 128 * j; const f32x2 e2 = (j < 4) ? *(const f32x2*)(pa + k) : *(const f32x2*)(pb + k - 512); v[2 * j] += e2[0]; v[2 * j + 1] += e2[1]; }
        }
        if (kind >= 1) {
            const bf16_t* yr = (const bf16_t*)(ws + (kind == 1 ? WS_Y : WS_Y2)) + (size_t)r * D;
            float yv[16]; float ss = 0.f;
#pragma unroll
            for (int j = 0; j < 8; ++j) { const unsigned raw = *(const unsigned*)(yr + 2 * lane + 128 * j); yv[2 * j] = lo16(raw); yv[2 * j + 1] = hi16(raw); ss += yv[2 * j] * yv[2 * j] + yv[2 * j + 1] * yv[2 * j + 1]; }
            ss = wave_sum(ss); const float rs = rsqrtf(ss * (1.0f / 1024.0f) + EPS);
            const float* gate = MOD + (size_t)(li * 9 + bidx) * 6144 + (kind == 1 ? 2 : 5) * 1024;
            const float* gp = inp(kind == 1 ? 7 : 9) + li * 1024;
#pragma unroll
            for (int j = 0; j < 8; ++j) { const int k = 2 * lane + 128 * j; const f32x2 g2 = *(const f32x2*)(gate + k), q2 = *(const f32x2*)(gp + k);
                v[2 * j] += g2[0] * ((yv[2 * j] * rs) * q2[0]); v[2 * j + 1] += g2[1] * ((yv[2 * j + 1] * rs) * q2[1]); }
        }
#pragma unroll
        for (int j = 0; j < 8; ++j) { f32x2 o; o[0] = v[2 * j]; o[1] = v[2 * j + 1]; *(f32x2*)(xout + 2 * lane + 128 * j) = o; }
        if (need_h) {
            float ss2 = 0.f;
#pragma unroll
            for (int j = 0; j < 16; ++j) ss2 += v[j] * v[j];
            ss2 = wave_sum(ss2); const float rs2 = rsqrtf(ss2 * (1.0f / 1024.0f) + EPS);
            const float* gpre = inp(kind == 1 ? 8 : 6) + lh * 1024;
            const float* md = MOD + (size_t)(lh * 9 + bidx) * 6144 + (kind == 1 ? 3 * 1024 : 0);
            float hv[16];
#pragma unroll
            for (int j = 0; j < 8; ++j) { const int k = 2 * lane + 128 * j; const f32x2 g2 = *(const f32x2*)(gpre + k), sh = *(const f32x2*)(md + k), sc = *(const f32x2*)(md + 1024 + k);
                hv[2 * j] = ((v[2 * j] * rs2) * g2[0]) * (1.f + sc[0]) + sh[0]; hv[2 * j + 1] = ((v[2 * j + 1] * rs2) * g2[1]) * (1.f + sc[1]) + sh[1];
                *(unsigned*)(H + (size_t)r * D + k) = pkbf(hv[2 * j], hv[2 * j + 1]); }
            if (need_lr) {
                float acc[32];
#pragma unroll
                for (int c = 0; c < 32; ++c) acc[c] = 0.f;
#pragma unroll
                for (int j = 0; j < 8; ++j) {
                    const LAS f32x4* wp;
                    { LAS float* bp = wl + (lane + 256 * (j >> 2)) * 68; asm volatile("" : "+v"(bp)); wp = (const LAS f32x4*)(bp + 64 * 68 * (j & 3)); }
                    const float h0 = hv[2 * j], h1 = hv[2 * j + 1];
#pragma unroll
                    for (int q = 0; q < 16; ++q) { const f32x4 w4 = wp[q]; acc[2 * q] += h0 * w4[0] + h1 * w4[1]; acc[2 * q + 1] += h0 * w4[2] + h1 * w4[3];
                        if ((q & 7) == 7) __builtin_amdgcn_sched_barrier(0); } }
                float a16[16], a8[8], a4[4], a2[2];
                { const bool up = (lane & 32) != 0;
#pragma unroll
                  for (int c = 0; c < 16; ++c) { const float keep = up ? acc[c + 16] : acc[c], send = up ? acc[c] : acc[c + 16]; a16[c] = keep + __shfl_xor(send, 32); } }
                { const bool up = (lane & 16) != 0;
#pragma unroll
                  for (int c = 0; c < 8; ++c) { const float keep = up ? a16[c + 8] : a16[c], send = up ? a16[c] : a16[c + 8]; a8[c] = keep + __shfl_xor(send, 16); } }
                { const bool up = (lane & 8) != 0;
#pragma unroll
                  for (int c = 0; c < 4; ++c) { const float keep = up ? a8[c + 4] : a8[c], send = up ? a8[c] : a8[c + 4]; a4[c] = keep + __shfl_xor(send, 8); } }
                { const bool up = (lane & 4) != 0;
#pragma unroll
                  for (int c = 0; c < 2; ++c) { const float keep = up ? a4[c + 2] : a4[c], send = up ? a4[c] : a4[c + 2]; a2[c] = keep + __shfl_xor(send, 4); } }
                float a1;
                { const bool up = (lane & 2) != 0; const float keep = up ? a2[1] : a2[0], send = up ? a2[0] : a2[1]; a1 = keep + __shfl_xor(send, 2); }
                a1 += __shfl_xor(a1, 1);
                if ((lane & 1) == 0) LR[(size_t)r * 32 + (lane >> 1)] = a1;
            }
        }
    }
}

__device__ __forceinline__ void f1_item(const Params& p, LAS unsigned char* lds, int tid, int lane, int wave, int it) {
    unsigned char* ws = wsp();
    const bf16_t* PB = (const bf16_t*)(ws + WS_PB);
    int b, tb, L, seqbase; bf16_t* ZT;
    if (it < 128) { b = it >> 4; tb = it & 15; L = SEQ; seqbase = b * SEQ; ZT = (bf16_t*)(ws + WS_ZT); }
    else { const int ic = it - 128; b = ic >> 1; tb = ic & 1; L = CTXL; seqbase = MLAT + b * CTXL; ZT = (bf16_t*)(ws + WS_ZTC); }
    const int Lh = L >> 1;
    LAS bf16_t* ue_s = (LAS bf16_t*)(lds);
    LAS bf16_t* uo_s = (LAS bf16_t*)(lds + 33792);
    LAS bf16_t* cc_s = (LAS bf16_t*)(lds + 67584);
    LAS bf16_t* sc_s = (LAS bf16_t*)(lds + 76800);
    LAS float* sp_s = (LAS float*)(lds + 86016);
#pragma unroll
    for (int q = 0; q < 4; ++q) {
        const int e = tid + NTHR * q, t = e >> 5, c8 = e & 31, l = 64 * tb + t;
        const u32x4 a = *(const u32x4*)(PB + (size_t)(seqbase + l) * NPB + c8 * 8);
        u32x4 m = (u32x4){0u, 0u, 0u, 0u};
        if (l > 0) m = *(const u32x4*)(PB + (size_t)(seqbase + L - l) * NPB + c8 * 8);
        u32x4 se, so;
#pragma unroll
        for (int w = 0; w < 4; ++w) { const float a0 = lo16(a[w]), a1 = hi16(a[w]), m0 = lo16(m[w]), m1 = hi16(m[w]);
            se[w] = pkbf(a0 + m0, a1 + m1); so[w] = (l > 0) ? pkbf(a0 - m0, a1 - m1) : 0u; }
        *(LAS u32x4*)(ue_s + t * 264 + c8 * 8) = se; *(LAS u32x4*)(uo_s + t * 264 + c8 * 8) = so;
    }
    if (tb == 0 && tid < 256) sp_s[tid] = bf2f(PB[(size_t)(seqbase + Lh) * NPB + tid]);
    __syncthreads();
    const int fr = lane & 15, fq = lane >> 4;
    const int g = wave >> 1, typ = wave & 1;
    const LAS bf16_t* src = typ ? uo_s : ue_s; const LAS bf16_t* mat = typ ? sc_s : cc_s;
#pragma unroll
    for (int lt = 0; lt < 4; ++lt) {
        bf16x8 a0 = *(const LAS bf16x8*)(src + (16 * lt + fr) * 264 + 64 * g + 8 * fq), a1 = *(const LAS bf16x8*)(src + (16 * lt + fr) * 264 + 64 * g + 32 + 8 * fq);
#pragma unroll
        for (int ct = 0; ct < 4; ++ct) {
            const bf16x8 b0 = *(const LAS bf16x8*)(mat + (16 * ct + fr) * 72 + 8 * fq), b1 = *(const LAS bf16x8*)(mat + (16 * ct + fr) * 72 + 32 + 8 * fq);
            f32x4 acc = (f32x4){0.f, 0.f, 0.f, 0.f};
            acc = __builtin_amdgcn_mfma_f32_16x16x32_bf16(a0, b0, acc, 0, 0, 0);
            acc = __builtin_amdgcn_mfma_f32_16x16x32_bf16(a1, b1, acc, 0, 0, 0);
            if (typ == 1 && tb == 0 && lt == 0 && fq == 0) {
                float s = 0.f;
                for (int c = 0; c < 64; ++c) s += sp_s[64 * g + c] * bf2f(cc_s[(16 * ct + fr) * 72 + c]);
                acc[0] = s;
            }
            const int n = b * 256 + g * 64 + 16 * ct + fr, kidx = typ * Lh + 64 * tb + 16 * lt + 4 * fq;
            u32x2 o; o[0] = pkbf(acc[0], acc[1]); o[1] = pkbf(acc[2], acc[3]);
            *(u32x2*)(ZT + (size_t)n * L + kidx) = o;
        }
    }
    __syncthreads();
}

__device__ __forceinline__ float logsig_z(const LAS float* lrow, const float (&wd)[16], float bd) {
    const LAS f32x4* lp = (const LAS f32x4*)lrow; float z = bd;
#pragma unroll
    for (int q = 0; q < 4; ++q) { const f32x4 l4 = lp[q]; z += l4[0] * wd[4 * q] + l4[1] * wd[4 * q + 1] + l4[2] * wd[4 * q + 2] + l4[3] * wd[4 * q + 3]; }
    return logsig16(z);
}

__device__ __forceinline__ void g1_item(const Params& p, LAS unsigned char* lds, int tid, int lane, int wave, int li, int it) {
    unsigned char* ws = wsp();
    const int dir = it & 1, h = (it >> 1) & 3, bc = it >> 3, cidx = bc % NCH, b = bc / NCH;
    const int row0 = cidx < 4 ? MLAT + b * CTXL + cidx * 64 : b * SEQ + (cidx - 4) * 64;
    const int unit = (b * 4 + h) * 2 + dir;
    LAS float* lr_s = (LAS float*)(lds);
    LAS float* wd_s = (LAS float*)(lds + 4096);
    LAS float* seg_s = (LAS float*)(lds + 8192);
    LAS bf16_t* ku_s = (LAS bf16_t*)(lds + 10240);
    LAS bf16_t* v_s = (LAS bf16_t*)(lds + 19456);
    const bf16_t* PA = (const bf16_t*)(ws + WS_PA);
    const float* LR = (const float*)(ws + WS_LR);
    const float* wdec = inp(dir ? 13 : 11) + li * 16 * 256; const float* bdec = inp(dir ? 14 : 12) + li * 256;
    const int d = tid & 63, tg = wave;
#pragma unroll
    for (int q = 0; q < 2; ++q) { const int e = tid + NTHR * q; const int t = e >> 4, rr = e & 15; lr_s[e] = LR[(size_t)(row0 + t) * 32 + dir * 16 + rr];
        wd_s[e] = wdec[(e >> 6) * 256 + h * 64 + (e & 63)];
        *(LAS u32x4*)(v_s + t * 136 + rr * 8) = *(const u32x4*)(PA + (size_t)(row0 + t) * NPA + 256 + h * 128 + rr * 8); }
    float kk[8];
#pragma unroll
    for (int i = 0; i < 8; ++i) kk[i] = bf2f(PA[(size_t)(row0 + 8 * tg + i) * NPA + h * 64 + d]);
    const float bd = bdec[h * 64 + d];
    __syncthreads();
    float wd[16];
#pragma unroll
    for (int r = 0; r < 16; ++r) wd[r] = wd_s[r * 64 + d];
    float c[8];
#pragma unroll
    for (int i = 0; i < 8; ++i) c[i] = logsig_z(lr_s + (8 * tg + i) * 16, wd, bd);
    if (dir == 0) {
#pragma unroll
        for (int i = 1; i < 8; ++i) c[i] += c[i - 1];
    } else {
#pragma unroll
        for (int i = 6; i >= 0; --i) c[i] += c[i + 1];
    }
    seg_s[tg * 64 + d] = dir == 0 ? c[7] : c[0];
    __syncthreads();
    float off = 0.f, tot = 0.f;
#pragma unroll
    for (int g = 0; g < 8; ++g) { const float s = seg_s[g * 64 + d]; tot += s; if (dir == 0 ? (g < tg) : (g > tg)) off += s; }
    const float base = tot - off;
    u32x4 pk;
    pk[0] = pkbf(kk[0] * __expf(base - c[0]), kk[1] * __expf(base - c[1])); pk[1] = pkbf(kk[2] * __expf(base - c[2]), kk[3] * __expf(base - c[3]));
    pk[2] = pkbf(kk[4] * __expf(base - c[4]), kk[5] * __expf(base - c[5])); pk[3] = pkbf(kk[6] * __expf(base - c[6]), kk[7] * __expf(base - c[7]));
    *(LAS u32x4*)(ku_s + d * 72 + 8 * tg) = pk;
    if (tg == 0) ((float*)(ws + WS_DEC))[(size_t)(unit * NCH + cidx) * 64 + d] = __expf(tot);
    __syncthreads();
    const int fr = lane & 15, fq = lane >> 4;
    bf16x8 vb[2];
#pragma unroll
    for (int ks = 0; ks < 2; ++ks)
#pragma unroll
        for (int j = 0; j < 8; ++j) vb[ks][j] = (short)v_s[(32 * ks + 8 * fq + j) * 136 + 16 * wave + fr];
    bf16_t* dso = (bf16_t*)(ws + WS_H) + ((size_t)(unit * NCH + cidx) * 128 + 16 * wave + fr) * 64 + 4 * fq;
#pragma unroll
    for (int dt = 0; dt < 4; ++dt) {
        f32x4 acc = (f32x4){0.f, 0.f, 0.f, 0.f};
#pragma unroll
        for (int ks = 0; ks < 2; ++ks) { const bf16x8 a = *(const LAS bf16x8*)(ku_s + (16 * dt + fr) * 72 + 32 * ks + 8 * fq); acc = __builtin_amdgcn_mfma_f32_16x16x32_bf16(a, vb[ks], acc, 0, 0, 0); }
        u32x2 o; o[0] = pkbf(acc[0], acc[1]); o[1] = pkbf(acc[2], acc[3]);
        *(u32x2*)(dso + 16 * dt) = o;
    }
    __syncthreads();
}

__device__ __forceinline__ void phase_x1(const Params& p, LAS unsigned char* lds, int tid, int lane, int wave, int bid, int G, int li) {
    unsigned char* ws = wsp();
#ifndef DBG_X1
#define DBG_X1 7
#endif
    if (DBG_X1 & 1) {
        LAS bf16_t* cc_s = (LAS bf16_t*)(lds + 67584); LAS bf16_t* sc_s = (LAS bf16_t*)(lds + 76800);
        for (int e = tid; e < 4096; e += NTHR) { const int cp = e >> 6, c = e & 63; const float x = (float)((cp * c) & 63) * (1.0f / 32.0f); cc_s[cp * 72 + c] = f2bf(cospif(x) * 0.125f); sc_s[cp * 72 + c] = f2bf(sinpif(x) * 0.125f); }
        __syncthreads();
        const int nF1 = li == 0 ? 144 : 128;
        for (int it = bid; it < nF1; it += G) f1_item(p, lds, tid, lane, wave, it);
    }
    if (DBG_X1 & 2) {
        const bf16_t* PB = (const bf16_t*)(ws + WS_PB); bf16_t* YC = (bf16_t*)(ws + WS_YC);
        const float* cw = inp(16) + li * 3 * 256; const float* cb = inp(17) + li * 256;
        const int nrows = li == 0 ? MTOT : MLAT;
        for (int it = bid * NTHR + tid; it < nrows * 32; it += G * NTHR) {
            const int r = it >> 5, c8 = it & 31;
            const int t = r < MLAT ? (r & 2047) : ((r - MLAT) & 255); const int L = r < MLAT ? SEQ : CTXL;
            const bf16_t* row = PB + (size_t)r * NPB + c8 * 8;
            const u32x4 bg = *(const u32x4*)(row + 256), c0 = *(const u32x4*)(row + 512), u0 = *(const u32x4*)(row + 768);
            u32x4 cm = (u32x4){0u, 0u, 0u, 0u}, um = cm, cp = cm, up = cm;
            if (t > 0) { cm = *(const u32x4*)(row - NPB + 512); um = *(const u32x4*)(row - NPB + 768); }
            if (t < L - 1) { cp = *(const u32x4*)(row + NPB + 512); up = *(const u32x4*)(row + NPB + 768); }
            u32x4 o;
#pragma unroll
            for (int w = 0; w < 4; ++w) {
                const int ch = c8 * 8 + 2 * w;
                const float zl0 = lo16(cm[w]) * lo16(um[w]), zl1 = hi16(cm[w]) * hi16(um[w]);
                const float zc0 = lo16(c0[w]) * lo16(u0[w]), zc1 = hi16(c0[w]) * hi16(u0[w]);
                const float zr0 = lo16(cp[w]) * lo16(up[w]), zr1 = hi16(cp[w]) * hi16(up[w]);
                const float y0 = cw[ch] * zl0 + cw[256 + ch] * zc0 + cw[512 + ch] * zr0 + cb[ch];
                const float y1 = cw[ch + 1] * zl1 + cw[256 + ch + 1] * zc1 + cw[512 + ch + 1] * zr1 + cb[ch + 1];
                o[w] = pkbf(lo16(bg[w]) * y0, hi16(bg[w]) * y1);
            }
            *(u32x4*)(YC + (size_t)r * D + 768 + c8 * 8) = o;
        }
    }
    if (DBG_X1 & 4) for (int it = bid; it < NB * NCH * 8; it += G) g1_item(p, lds, tid, lane, wave, li, it);
}

__device__ __forceinline__ void scan_states(const Params& p, int tix0, int tstride) {
    unsigned char* ws = wsp();
    const bf16_t* DS = (const bf16_t*)(ws + WS_H); bf16_t* S = (bf16_t*)(ws + WS_PB); const float* DEC = (const float*)(ws + WS_DEC);
    for (int tix = tix0; tix < 64 * 128 * 8; tix += tstride) {
        const int unit = tix >> 10, v = (tix >> 3) & 127, dg = tix & 7, dir = unit & 1;
        float s[8];
#pragma unroll
        for (int j = 0; j < 8; ++j) s[j] = 0.f;
#pragma unroll 4
        for (int step = 0; step < NCH; ++step) {
            const int cidx = dir == 0 ? step : (step < 4 ? 3 - step : 39 - step);
            const size_t a = ((size_t)(unit * NCH + cidx) * 128 + v) * 64 + dg * 8;
            const u32x4 dsv = *(const u32x4*)(DS + a);
            const f32x4 d0 = *(const f32x4*)(DEC + (size_t)(unit * NCH + cidx) * 64 + dg * 8), d1 = *(const f32x4*)(DEC + (size_t)(unit * NCH + cidx) * 64 + dg * 8 + 4);
            u32x4 o; o[0] = pkbf(s[0], s[1]); o[1] = pkbf(s[2], s[3]); o[2] = pkbf(s[4], s[5]); o[3] = pkbf(s[6], s[7]);
            *(u32x4*)(S + a) = o;
            s[0] = d0[0] * s[0] + lo16(dsv[0]); s[1] = d0[1] * s[1] + hi16(dsv[0]); s[2] = d0[2] * s[2] + lo16(dsv[1]); s[3] = d0[3] * s[3] + hi16(dsv[1]);
            s[4] = d1[0] * s[4] + lo16(dsv[2]); s[5] = d1[1] * s[5] + hi16(dsv[2]); s[6] = d1[2] * s[6] + lo16(dsv[3]); s[7] = d1[3] * s[7] + hi16(dsv[3]);
        }
    }
}

__device__ __forceinline__ void g3_item(const Params& p, LAS unsigned char* lds, int tid, int lane, int wave, int li, int b, int cidx, int h) {
    unsigned char* ws = wsp();
    const int row0 = cidx < 4 ? MLAT + b * CTXL + cidx * 64 : b * SEQ + (cidx - 4) * 64;
    LAS float* lr_s = (LAS float*)(lds);
    LAS float* wd_s = (LAS float*)(lds + 8192);
    LAS float* seg_s = (LAS float*)(lds + 16384);
    LAS float* gm_s = (LAS float*)(lds + 18432);
    LAS float* ssq_s = (LAS float*)(lds + 18688);
    LAS bf16_t* v_s = (LAS bf16_t*)(lds + 20736);
    LAS bf16_t* qt_s = (LAS bf16_t*)(lds + 38144);
    LAS bf16_t* kt_s = (LAS bf16_t*)(lds + 47360);
    LAS bf16_t* ao_s = (LAS bf16_t*)(lds + 56576);
    const bf16_t* PA = (const bf16_t*)(ws + WS_PA);
    const float* LR = (const float*)(ws + WS_LR);
    const bf16_t* S = (const bf16_t*)(ws + WS_PB);
    const int d = tid & 63, tg = wave, fr = lane & 15, fq = lane >> 4;
#pragma unroll
    for (int q = 0; q < 4; ++q) { const int e = tid + NTHR * q; lr_s[e] = LR[(size_t)(row0 + (e >> 5)) * 32 + (e & 31)];
        const int e1 = e & 1023; wd_s[e] = inp((e >> 10) ? 13 : 11)[li * 4096 + (e1 >> 6) * 256 + h * 64 + (e1 & 63)]; }
#pragma unroll
    for (int q = 0; q < 2; ++q) { const int e = tid + NTHR * q; const int t = e >> 4, rr = e & 15;
        *(LAS u32x4*)(v_s + t * 136 + rr * 8) = *(const u32x4*)(PA + (size_t)(row0 + t) * NPA + 256 + h * 128 + rr * 8); }
    float kk[8], qq[8];
#pragma unroll
    for (int i = 0; i < 8; ++i) { const bf16_t* rp = PA + (size_t)(row0 + 8 * tg + i) * NPA + h * 64 + d; kk[i] = bf2f(rp[0]); qq[i] = bf2f(rp[768]) * 0.125f; }
    __syncthreads();
    bf16x8 vb[2];
#pragma unroll
    for (int ks = 0; ks < 2; ++ks)
#pragma unroll
        for (int j = 0; j < 8; ++j) vb[ks][j] = (short)v_s[(32 * ks + 8 * fq + j) * 136 + 16 * wave + fr];
    f32x4 oacc[4];
#pragma unroll
    for (int i = 0; i < 4; ++i) oacc[i] = (f32x4){0.f, 0.f, 0.f, 0.f};
#pragma unroll 1
    for (int dir = 0; dir < 2; ++dir) {
        const int unit = (b * 4 + h) * 2 + dir;
        const bf16_t* Sp = S + ((size_t)(unit * NCH + cidx) * 128 + 16 * wave + fr) * 64 + 8 * fq;
        const bf16x8 sf0 = *(const bf16x8*)(Sp), sf1 = *(const bf16x8*)(Sp + 32);
        const float bd = inp(dir ? 14 : 12)[li * 256 + h * 64 + d];
        float wd[16];
#pragma unroll
        for (int r = 0; r < 16; ++r) wd[r] = wd_s[dir * 1024 + r * 64 + d];
        float c[8];
#pragma unroll
        for (int i = 0; i < 8; ++i) c[i] = logsig_z(lr_s + (8 * tg + i) * 32 + dir * 16, wd, bd);
        if (dir == 0) {
#pragma unroll
            for (int i = 1; i < 8; ++i) c[i] += c[i - 1];
        } else {
#pragma unroll
            for (int i = 6; i >= 0; --i) c[i] += c[i + 1];
        }
        seg_s[tg * 64 + d] = dir == 0 ? c[7] : c[0];
        __syncthreads();
        float off = 0.f;
#pragma unroll
        for (int g = 0; g < 8; ++g) { const float s = seg_s[g * 64 + d]; if (dir == 0 ? (g < tg) : (g > tg)) off += s; }
#pragma unroll
        for (int i = 0; i < 8; ++i) c[i] += off;
        if (dir == 0 ? (tg == 3) : (tg == 4)) gm_s[d] = dir == 0 ? c[7] : c[0];
        __syncthreads();
        const float gm = gm_s[d];
#pragma unroll
        for (int i = 0; i < 8; ++i) { const int t = 8 * tg + i;
            qt_s[t * 72 + d] = f2bf(qq[i] * __expf(c[i] - gm)); kt_s[t * 72 + d] = f2bf(kk[i] * __expf(gm - c[i])); ao_s[t * 136 + 64 + d] = f2bf(qq[i] * __expf(c[i])); }
        __syncthreads();
        {
            const int it = wave >> 1;
            const bf16x8 a0 = *(const LAS bf16x8*)(qt_s + (16 * it + fr) * 72 + 8 * fq), a1 = *(const LAS bf16x8*)(qt_s + (16 * it + fr) * 72 + 32 + 8 * fq);
#pragma unroll
            for (int jj = 0; jj < 2; ++jj) { const int jt = 2 * (wave & 1) + jj;
                const bf16x8 b0 = *(const LAS bf16x8*)(kt_s + (16 * jt + fr) * 72 + 8 * fq), b1 = *(const LAS bf16x8*)(kt_s + (16 * jt + fr) * 72 + 32 + 8 * fq);
                f32x4 acc = (f32x4){0.f, 0.f, 0.f, 0.f};
                acc = __builtin_amdgcn_mfma_f32_16x16x32_bf16(a0, b0, acc, 0, 0, 0);
                acc = __builtin_amdgcn_mfma_f32_16x16x32_bf16(a1, b1, acc, 0, 0, 0);
#pragma unroll
                for (int ii = 0; ii < 4; ++ii) { const int ir = 16 * it + 4 * fq + ii, jc = 16 * jt + fr; const bool keep = dir == 0 ? (jc <= ir) : (jc >= ir);
                    ao_s[ir * 136 + jc] = f2bf(keep ? acc[ii] : 0.f); } }
        }
        __syncthreads();
#pragma unroll
        for (int it = 0; it < 4; ++it) {
            const LAS bf16_t* ap = ao_s + (16 * it + fr) * 136 + 8 * fq;
            oacc[it] = __builtin_amdgcn_mfma_f32_16x16x32_bf16(*(const LAS bf16x8*)(ap), vb[0], oacc[it], 0, 0, 0);
            oacc[it] = __builtin_amdgcn_mfma_f32_16x16x32_bf16(*(const LAS bf16x8*)(ap + 32), vb[1], oacc[it], 0, 0, 0);
            oacc[it] = __builtin_amdgcn_mfma_f32_16x16x32_bf16(*(const LAS bf16x8*)(ap + 64), sf0, oacc[it], 0, 0, 0);
            oacc[it] = __builtin_amdgcn_mfma_f32_16x16x32_bf16(*(const LAS bf16x8*)(ap + 96), sf1, oacc[it], 0, 0, 0);
        }
        __syncthreads();
    }
#pragma unroll
    for (int it = 0; it < 4; ++it)
#pragma unroll
        for (int ii = 0; ii < 4; ++ii) { float sq = oacc[it][ii] * oacc[it][ii];
            sq += __shfl_xor(sq, 1); sq += __shfl_xor(sq, 2); sq += __shfl_xor(sq, 4); sq += __shfl_xor(sq, 8);
            if (fr == 0) ssq_s[wave * 64 + 16 * it + 4 * fq + ii] = sq; }
    __syncthreads();
    const int vcol = h * 128 + 16 * wave + fr;
    const float gn = inp(15)[li * 512 + vcol];
    bf16_t* YC = (bf16_t*)(ws + WS_YC);
#pragma unroll
    for (int it = 0; it < 4; ++it)
#pragma unroll
        for (int ii = 0; ii < 4; ++ii) { const int i = 16 * it + 4 * fq + ii; float tot = 0.f;
#pragma unroll
            for (int w = 0; w < 8; ++w) tot += ssq_s[w * 64 + i];
            const float rs = rsqrtf(tot * (1.0f / 128.0f) + EPS);
            const float rv = bf2f(PA[(size_t)(row0 + i) * NPA + 1024 + vcol]);
            YC[(size_t)(row0 + i) * D + vcol] = f2bf(((oacc[it][ii] * rs) * gn) * silu_f(rv)); }
    __syncthreads();
}


#ifndef DBG_STOP
#define DBG_STOP 99
#endif
__device__ __forceinline__ void dbg_digest() {
    const int bid = blockIdx.x, tid = threadIdx.x, G = gridDim.x;
    const unsigned* w = (const unsigned*)wsp(); unsigned* o = (unsigned*)outp();
    const size_t NW = WS_END / 4, NO = (size_t)MLAT * D;
    for (size_t i = (size_t)bid * NTHR + tid; i < NO; i += (size_t)G * NTHR) {
        unsigned x = o[i];
        for (size_t j = i; j < NW; j += NO) x ^= w[j];
        ((float*)o)[i] = (float)((x ^ (x >> 16)) & 0xFFFFu);
    }
}
#define DBG_CHECK(k) do { if (DBG_STOP == (k)) { GRID_SYNC(); FRESH(); dbg_digest(); return; } } while (0)
#define GEMM_CALL(EPI, g, S, E) pg8::gemm_phase<EPI, pg8::StaticOrder, true, true>(lds, g, S, E)

__global__ void __launch_bounds__(NTHR, 2) hybrid_fwd(Params p) {
    extern __shared__ __attribute__((aligned(16))) unsigned char lds_raw[];
    LAS unsigned char* lds = (LAS unsigned char*)lds_raw;
    cg::grid_group grid = cg::this_grid();
    int tid, lane, wave, bid; const int G = gridDim.x;
    unsigned char* ws; bf16_t *H, *PA, *PB, *YC;
#define FRESH() do { int t_ = threadIdx.x; asm volatile("" : "+v"(t_)); tid = t_; lane = tid & 63; wave = __builtin_amdgcn_readfirstlane(tid >> 6); int b_ = blockIdx.x; asm volatile("" : "+s"(b_)); bid = b_; \
        ws = wsp(); H = (bf16_t*)(ws + WS_H); PA = (bf16_t*)(ws + WS_PA); PB = (bf16_t*)(ws + WS_PB); YC = (bf16_t*)(ws + WS_YC); } while (0)
#define GRID_SYNC() do { asm volatile("s_waitcnt vmcnt(0) lgkmcnt(0)" ::: "memory"); __builtin_amdgcn_fence(__ATOMIC_RELEASE, "agent"); grid.sync(); \
        __builtin_amdgcn_fence(__ATOMIC_ACQUIRE, "agent"); asm volatile("s_waitcnt vmcnt(0)" ::: "memory"); } while (0)
    FRESH();

    phase_prologue(p, lds, tid, lane, wave, bid, G);
    DBG_CHECK(0);
    GRID_SYNC(); FRESH();
    phase_rows(p, lds, tid, lane, wave, bid, G, 0, 0);
    DBG_CHECK(1);
    GRID_SYNC(); FRESH();
#pragma unroll 1
    for (int li = 0; li < 2; ++li) {
        {
            const bf16_t* W = (const bf16_t*)(ws + WS_WIN) + (size_t)li * NP * 1024;
            const int M1 = li == 0 ? MTOT : MLAT;
            pg8::Gemm g{H, W, M1, NP, 1024}; pg8::StaticOrder S; S.init(M1, NP, G, bid);
            EpiStore E{PA, NPA, PB, NPB, 6};
            GEMM_CALL(EpiStore, g, S, E);
            if (li == 1) {
                const int shift = ((MLAT / 256) * (NP / 256)) % G;
                pg8::Gemm g2{H + (size_t)MLAT * 1024, W, MCTX, 768, 1024}; pg8::StaticOrder S2; S2.init(MCTX, 768, G, (bid - shift + G) % G);
                EpiStore E2{PA + (size_t)MLAT * NPA, NPA, PB, NPB, 6};
                GEMM_CALL(EpiStore, g2, S2, E2);
            }
        }
        DBG_CHECK(2 + li * 9 + 0);
        GRID_SYNC(); FRESH();
        phase_x1(p, lds, tid, lane, wave, bid, G, li);
        DBG_CHECK(2 + li * 9 + 1);
        GRID_SYNC(); FRESH();
        {
            const int nfb = 64;
            if (bid < nfb) {
                pg8::Gemm g{(const bf16_t*)(ws + WS_DL), (const bf16_t*)(ws + WS_ZT), SEQ, NB * 256, SEQ}; pg8::StaticOrder S; S.init(SEQ, NB * 256, nfb, bid);
                EpiF2 E{YC + 512, SEQ};
                GEMM_CALL(EpiF2, g, S, E);
            } else {
                if (li == 0 && bid < nfb + 8) {
                    pg8::Gemm g{(const bf16_t*)(ws + WS_DLC), (const bf16_t*)(ws + WS_ZTC), CTXL, NB * 256, CTXL}; pg8::StaticOrder S; S.init(CTXL, NB * 256, 8, bid - nfb);
                    EpiF2 E{YC + (size_t)MLAT * D + 512, CTXL};
                    GEMM_CALL(EpiF2, g, S, E);
                }
                scan_states(p, (bid - nfb) * NTHR + tid, (G - nfb) * NTHR);
            }
        }
        DBG_CHECK(2 + li * 9 + 2);
        GRID_SYNC(); FRESH();
        if (li == 0) { for (int it = bid; it < NB * NCH * 4; it += G) { const int b = it / (NCH * 4), rem = it % (NCH * 4); g3_item(p, lds, tid, lane, wave, li, b, rem >> 2, rem & 3); } }
        else { for (int it = bid; it < NB * 32 * 4; it += G) g3_item(p, lds, tid, lane, wave, li, it >> 7, 4 + ((it >> 2) & 31), it & 3); }
        DBG_CHECK(2 + li * 9 + 3);
        GRID_SYNC(); FRESH();
        {
            const int M1 = li == 0 ? MTOT : MLAT;
            pg8::Gemm g{YC, (const bf16_t*)(ws + WS_WOUT) + (size_t)li * 1024 * 1024, M1, 1024, 1024}; pg8::StaticOrder S; S.init(M1, 1024, G, bid);
            EpiStore E{(bf16_t*)(ws + WS_Y), 1024, nullptr, 0, 1 << 20};
            GEMM_CALL(EpiStore, g, S, E);
        }
        DBG_CHECK(2 + li * 9 + 4);
        GRID_SYNC(); FRESH();
        phase_rows(p, lds, tid, lane, wave, bid, G, 1, li);
        DBG_CHECK(2 + li * 9 + 5);
        GRID_SYNC(); FRESH();
        {
            const int M1 = li == 0 ? MTOT : MLAT;
            pg8::Gemm g{H, (const bf16_t*)(ws + WS_WFI) + (size_t)li * 2 * FFH * 1024, M1, 2 * FFH, 1024}; pg8::StaticOrder S; S.init(M1, 2 * FFH, G, bid);
            EpiSwiglu E{(bf16_t*)(ws + WS_HID), FFH};
            GEMM_CALL(EpiSwiglu, g, S, E);
        }
        DBG_CHECK(2 + li * 9 + 6);
        GRID_SYNC(); FRESH();
        {
            const int M1 = li == 0 ? MTOT : MLAT;
            pg8::Gemm g{(const bf16_t*)(ws + WS_HID), (const bf16_t*)(ws + WS_WFO) + (size_t)li * 1024 * FFH, M1, 1024, FFH}; pg8::StaticOrder S; S.init(M1, 1024, G, bid);
            EpiStore E{(bf16_t*)(ws + WS_Y2), 1024, nullptr, 0, 1 << 20};
            GEMM_CALL(EpiStore, g, S, E);
        }
        DBG_CHECK(2 + li * 9 + 7);
        GRID_SYNC(); FRESH();
        phase_rows(p, lds, tid, lane, wave, bid, G, 2, li);
        DBG_CHECK(2 + li * 9 + 8);
        if (li == 0) { GRID_SYNC(); FRESH(); }
    }
}

extern "C" void kernel_launch(void* const* d_in, const int* in_sizes, int n_in, void* d_out, int out_size, void* d_ws, size_t ws_size, hipStream_t stream) {
    static int grid = 0;
    if (grid == 0) {
        if (n_in != 21 || out_size != MLAT * D || ws_size < WS_END) { fprintf(stderr, "kernel_launch: unexpected problem (n_in %d, out %d, ws %zu)\n", n_in, out_size, ws_size); grid = -1; return; }
        int dev = 0, cus = 0, per_cu = 0;
        hipGetDevice(&dev);
        hipDeviceGetAttribute(&cus, hipDeviceAttributeMultiprocessorCount, dev);
        hipFuncSetAttribute((const void*)hybrid_fwd, hipFuncAttributeMaxDynamicSharedMemorySize, LDS_BYTES);
        hipOccupancyMaxActiveBlocksPerMultiprocessor(&per_cu, (const void*)hybrid_fwd, NTHR, LDS_BYTES);
        if (per_cu < 1) per_cu = 1;
        grid = cus * 1;
        if (grid < 128) { fprintf(stderr, "kernel_launch: too few CUs (%d)\n", cus); grid = -1; return; }
    }
    if (grid < 0) return;
    Params p{};
    for (int i = 0; i < 21; ++i) p.in[i] = (const float*)d_in[i];
    p.out = (float*)d_out; p.ws = (unsigned char*)d_ws;
    void* args[] = {&p};
    hipError_t e = hipLaunchCooperativeKernel((const void*)hybrid_fwd, dim3(grid), dim3(NTHR), args, LDS_BYTES, stream);
    if (e != hipSuccess) fprintf(stderr, "cooperative launch failed: %s (grid %d)\n", hipGetErrorString(e), grid);
}
```

```cpp
#include <hip/hip_runtime.h>
#include <hip/hip_cooperative_groups.h>
#include <cstdio>
#include <cstdint>
namespace cg = cooperative_groups;
namespace pg8 {
#define PG8_LAS __attribute__((address_space(3)))
typedef unsigned short bf16_t;
typedef short bf16x8 __attribute__((ext_vector_type(8)));
typedef float f32x4 __attribute__((ext_vector_type(4)));
typedef unsigned u32x4 __attribute__((ext_vector_type(4)));
constexpr int BM = 256, BK = 64, HALF = 128, HTB = HALF * BK * 2  , STAGE_BYTES = 8 * HTB, NXCD = 8, WGM = 8;

__host__ __device__ __forceinline__ int lds_byte(int r, int c) { const int st = (r >> 4) * 2 + (c >> 5), rr = r & 15, cc = c & 31, ob = rr * 64 + cc * 2; return st * 1024 + (ob ^ (((ob >> 9) & 1) << 5)); }
__host__ __device__ __forceinline__ void stage_rc(int b, int& R, int& C) { const int st = b / 1024, sb = b % 1024, swz = sb ^ (((sb >> 9) & 1) << 5); R = (st >> 1) * 16 + swz / 64; C = (st & 1) * 32 + (swz % 64) / 2; }
__host__ __device__ __forceinline__ int perm32(int rho) { const int n = rho >> 4, i = rho & 15; return 8 * (i >> 2) + 4 * n + (i & 3); }

struct Unit { int pm, pn; };
struct Gemm { const bf16_t* A; const bf16_t* Bt; int M, N, K; };

struct StaticOrder {
    int nM, nN, nwg, G, c;
    __host__ __device__ void init(int M, int N, int G_, int c_) { nM = M / BM; nN = N / BM; nwg = nM * nN; G = G_; c = c_; }
    __host__ __device__ bool next(int i, Unit& u) const {
        const long L = (long)i * G + c; if (L >= nwg) return false;
        int wgid = (int)L; { const int q = nwg / NXCD, r = nwg % NXCD, xcd = wgid % NXCD, off = wgid / NXCD; wgid = (xcd < r ? xcd * (q + 1) : r * (q + 1) + (xcd - r) * q) + off; }
        const int nig = WGM * nN, gid = wgid / nig, fm = gid * WGM, gsz = (nM - fm) < WGM ? (nM - fm) : WGM;
        u.pm = fm + ((wgid % nig) % gsz); u.pn = (wgid % nig) / gsz; return true;
    }
    __device__ __forceinline__ void a_ready(const Unit&) const {}
    __device__ __forceinline__ void done(const Unit&) const {}
};

__device__ __forceinline__ unsigned cvt_pk_bf16(float lo, float hi) { unsigned r; asm volatile("v_cvt_pk_bf16_f32 %0, %1, %2" : "=v"(r) : "v"(lo), "v"(hi)); return r; }
template <class Epi, class Sched, bool ALIGN_EPI = false, bool SP2 = false>
__device__ __forceinline__ void gemm_phase(PG8_LAS unsigned char* lds, const Gemm g, const Sched& S, const Epi& E) {
    int tid_ = threadIdx.x; asm volatile("" : "+v"(tid_));
    const int tid = tid_, wid = __builtin_amdgcn_readfirstlane(tid >> 6), lane = tid & 63, wr = wid >> 2, wc = wid & 3, fr = lane & 15, fq = lane >> 4;
    const int K = g.K, nt = K / BK;
    unsigned voffA[2], voffB[2];
#pragma unroll
    for (int i = 0; i < 2; ++i) { int R, C; stage_rc(tid * 16 + i * 8192, R, C); const int Rb = Epi::PERM ? ((R & ~31) + perm32(R & 31)) : R;
        voffA[i] = (unsigned)(R * K + C) * 2u; voffB[i] = (unsigned)(Rb * K + C) * 2u; }
    const size_t kstep = (size_t)(BK * 2);
    const size_t hstep = (size_t)HALF * K * 2;
    const size_t tstep = 2 * hstep;
    const unsigned ldsw = (unsigned)wid * 1024u;
    const int aoff = lds_byte(wr * 64 + fr, fq * 8), boff = lds_byte(wc * 32 + fr, fq * 8);
#define PG8_SA(b, h) (((b) * 2 + (h)) * HTB)
#define PG8_SB(b, h) ((4 + (b) * 2 + (h)) * HTB)
#define PG8_STAGE(bufoff, gbase, voff) do { _Pragma("unroll") for (int _i = 0; _i < 2; ++_i) \
        __builtin_amdgcn_global_load_lds((const unsigned*)((const char*)(gbase) + (voff)[_i]), (PG8_LAS unsigned*)(lds + (bufoff) + ldsw + _i * 8192), 16, 0, 0); } while (0)
#define PG8_LDA(dst, b, h) do { _Pragma("unroll") for (int m = 0; m < 4; ++m) _Pragma("unroll") for (int k = 0; k < 2; ++k) dst[m][k] = *(const PG8_LAS bf16x8*)(lds + PG8_SA(b, h) + aoff + m * 2048 + k * 1024); } while (0)
#define PG8_LDB(dst, b, h) do { _Pragma("unroll") for (int n = 0; n < 2; ++n) _Pragma("unroll") for (int k = 0; k < 2; ++k) dst[n][k] = *(const PG8_LAS bf16x8*)(lds + PG8_SB(b, h) + boff + n * 2048 + k * 1024); } while (0)
#define PG8_MMA(ai, bj, At, Bt) do { __builtin_amdgcn_s_setprio(1); _Pragma("unroll") for (int m = 0; m < 4; ++m) _Pragma("unroll") for (int n = 0; n < 2; ++n) _Pragma("unroll") for (int k = 0; k < 2; ++k) \
        acc[ai][bj][m][n] = __builtin_amdgcn_mfma_f32_16x16x32_bf16(Bt[n][k], At[m][k], acc[ai][bj][m][n], 0, 0, 0); __builtin_amdgcn_s_setprio(0); } while (0)
#define PG8_WAIT_V(n) asm volatile("s_waitcnt vmcnt(" #n ")" ::: "memory")
#define PG8_WAIT_L(n) asm volatile("s_waitcnt lgkmcnt(" #n ")" ::: "memory")
#define PG8_BAR __builtin_amdgcn_s_barrier()
#define PG8_SCHED __builtin_amdgcn_sched_barrier(0)
    Unit cur, nxt; int ui = 0;
    if (!S.next(0, cur)) return;
    f32x4 acc[2][2][4][2];
#pragma unroll
    for (int a = 0; a < 2; ++a)
#pragma unroll
        for (int b = 0; b < 2; ++b)
#pragma unroll
            for (int m = 0; m < 4; ++m)
#pragma unroll
                for (int n = 0; n < 2; ++n) acc[a][b][m][n] = (f32x4){0.f, 0.f, 0.f, 0.f};
    bf16x8 At[4][2], B0[2][2], B1[2][2];
    const char* cA = (const char*)g.A + (size_t)cur.pm * tstep; const char* cB = (const char*)g.Bt + (size_t)cur.pn * tstep;
    S.a_ready(cur);
    if constexpr (SP2) {
        PG8_STAGE(PG8_SB(0, 0), cB, voffB); PG8_STAGE(PG8_SB(0, 1), cB + hstep, voffB); PG8_STAGE(PG8_SA(0, 0), cA, voffA); PG8_STAGE(PG8_SA(0, 1), cA + hstep, voffA);
        if (wr == 1) PG8_BAR;
        PG8_WAIT_V(2); PG8_BAR;
        PG8_STAGE(PG8_SB(1, 0), cB + kstep, voffB); PG8_STAGE(PG8_SA(1, 0), cA + kstep, voffA); PG8_STAGE(PG8_SB(1, 1), cB + hstep + kstep, voffB);
        PG8_WAIT_V(6); PG8_BAR;
    } else {
        PG8_STAGE(PG8_SB(0, 0), cB, voffB); PG8_STAGE(PG8_SA(0, 0), cA, voffA); PG8_STAGE(PG8_SB(0, 1), cB + hstep, voffB); PG8_STAGE(PG8_SA(0, 1), cA + hstep, voffA);
        if (wr == 1) PG8_BAR;
        PG8_WAIT_V(4); PG8_BAR;
        PG8_STAGE(PG8_SB(1, 0), cB + kstep, voffB); PG8_STAGE(PG8_SA(1, 0), cA + kstep, voffA); PG8_STAGE(PG8_SB(1, 1), cB + hstep + kstep, voffB);
        PG8_WAIT_V(6); PG8_BAR;
    }
    for (;;) {
        const bool has_next = S.next(ui + 1, nxt);
        const char* nA = has_next ? (const char*)g.A + (size_t)nxt.pm * tstep : cA; const char* nB = has_next ? (const char*)g.Bt + (size_t)nxt.pn * tstep : cB;
        for (int t = 0; t < nt; t += 2) {
            const bool last = (t == nt - 2);
            const char* a1 = cA + (size_t)(t + 1) * kstep;
            const char* a2 = last ? nA : cA + (size_t)(t + 2) * kstep; const char* b2 = last ? nB : cB + (size_t)(t + 2) * kstep;
            const char* a3 = a2 + kstep; const char* b3 = b2 + kstep;
            if (last && has_next) S.a_ready(nxt);
            if constexpr (SP2) {
            PG8_LDB(B0, 0, 0); PG8_LDB(B1, 0, 1); PG8_SCHED; PG8_LDA(At, 0, 0); PG8_STAGE(PG8_SA(1, 1), a1 + hstep, voffA);
            PG8_WAIT_V(8); PG8_WAIT_L(0); PG8_BAR; PG8_MMA(0, 0, At, B0); PG8_MMA(0, 1, At, B1); PG8_BAR; PG8_SCHED;
            PG8_LDA(At, 0, 1); PG8_STAGE(PG8_SB(0, 0), b2, voffB); PG8_STAGE(PG8_SB(0, 1), b2 + hstep, voffB); PG8_STAGE(PG8_SA(0, 0), a2, voffA);
            PG8_WAIT_V(8); PG8_WAIT_L(0); PG8_BAR; PG8_MMA(1, 0, At, B0); PG8_MMA(1, 1, At, B1); PG8_BAR; PG8_SCHED;
            PG8_LDB(B0, 1, 0); PG8_LDB(B1, 1, 1); PG8_SCHED; PG8_LDA(At, 1, 0); PG8_STAGE(PG8_SA(0, 1), a2 + hstep, voffA);
            PG8_WAIT_V(8); PG8_WAIT_L(0); PG8_BAR; PG8_MMA(0, 0, At, B0); PG8_MMA(0, 1, At, B1); PG8_BAR; PG8_SCHED;
            PG8_LDA(At, 1, 1); PG8_STAGE(PG8_SB(1, 0), b3, voffB); PG8_STAGE(PG8_SB(1, 1), b3 + hstep, voffB); PG8_STAGE(PG8_SA(1, 0), a3, voffA);
            PG8_WAIT_V(8); PG8_WAIT_L(0); PG8_BAR; PG8_MMA(1, 0, At, B0); PG8_MMA(1, 1, At, B1); PG8_BAR; PG8_SCHED;
            } else {
            PG8_LDB(B0, 0, 0); PG8_SCHED; PG8_LDA(At, 0, 0); PG8_STAGE(PG8_SA(1, 1), a1 + hstep, voffA);
            PG8_WAIT_L(8); PG8_BAR; PG8_WAIT_L(0); PG8_MMA(0, 0, At, B0); PG8_BAR; PG8_SCHED;
            PG8_LDB(B1, 0, 1); PG8_STAGE(PG8_SB(0, 0), b2, voffB);
            PG8_BAR; PG8_WAIT_L(0); PG8_MMA(0, 1, At, B1); PG8_BAR;
            PG8_LDA(At, 0, 1); PG8_STAGE(PG8_SA(0, 0), a2, voffA);
            PG8_BAR; PG8_WAIT_L(0); PG8_MMA(1, 0, At, B0); PG8_BAR; PG8_SCHED;
            PG8_STAGE(PG8_SB(0, 1), b2 + hstep, voffB);
            PG8_WAIT_V(6); PG8_BAR; PG8_MMA(1, 1, At, B1); PG8_BAR;
            PG8_LDB(B0, 1, 0); PG8_SCHED; PG8_LDA(At, 1, 0); PG8_STAGE(PG8_SA(0, 1), a2 + hstep, voffA);
            PG8_WAIT_L(8); PG8_BAR; PG8_WAIT_L(0); PG8_MMA(0, 0, At, B0); PG8_BAR; PG8_SCHED;
            PG8_LDB(B1, 1, 1); PG8_STAGE(PG8_SB(1, 0), b3, voffB);
            PG8_BAR; PG8_WAIT_L(0); PG8_MMA(0, 1, At, B1); PG8_BAR;
            PG8_LDA(At, 1, 1); PG8_STAGE(PG8_SA(1, 0), a3, voffA);
            PG8_BAR; PG8_WAIT_L(0); PG8_MMA(1, 0, At, B0); PG8_BAR; PG8_SCHED;
            PG8_STAGE(PG8_SB(1, 1), b3 + hstep, voffB);
            PG8_WAIT_V(6); PG8_BAR; PG8_MMA(1, 1, At, B1); PG8_BAR;
            }
        }
        if constexpr (ALIGN_EPI) { if (wr == 0) PG8_BAR; }
        if constexpr (!Epi::AFTER_DRAIN) { E(acc, cur, wr, wc, fr, fq); S.done(cur); }
        if (!has_next) break;
#pragma unroll
        for (int a = 0; a < 2; ++a)
#pragma unroll
            for (int b = 0; b < 2; ++b)
#pragma unroll
                for (int m = 0; m < 4; ++m)
#pragma unroll
                    for (int n = 0; n < 2; ++n) acc[a][b][m][n] = (f32x4){0.f, 0.f, 0.f, 0.f};
        cur = nxt; cA = nA; cB = nB; ++ui;
        if constexpr (ALIGN_EPI) { if (wr == 1) PG8_BAR; }
    }
    PG8_WAIT_V(0);
    if constexpr (!ALIGN_EPI) { if (wr == 0) PG8_BAR; }
    PG8_BAR;
    if constexpr (Epi::AFTER_DRAIN) { E.fused(acc, cur, wr, wc, fr, fq, lds, wid, lane); S.done(cur); }
#undef PG8_SA
#undef PG8_SB
#undef PG8_STAGE
#undef PG8_LDA
#undef PG8_LDB
#undef PG8_MMA
#undef PG8_WAIT_V
#undef PG8_WAIT_L
#undef PG8_BAR
#undef PG8_SCHED
}
}

#define LAS __attribute__((address_space(3)))
typedef unsigned short bf16_t;
typedef short bf16x8 __attribute__((ext_vector_type(8)));
typedef float f32x4 __attribute__((ext_vector_type(4)));
typedef float f32x2 __attribute__((ext_vector_type(2)));
typedef unsigned u32x4 __attribute__((ext_vector_type(4)));
typedef unsigned u32x2 __attribute__((ext_vector_type(2)));

constexpr int D = 1024, NB = 8, SEQ = 2048, CTXL = 256, MLAT = NB * SEQ, MCTX = NB * CTXL, MTOT = MLAT + MCTX;
constexpr int INC = 2592, NP = 2560, NPA = 1536, NPB = 1024, FFH = 2816;
constexpr int NCH = 36;
constexpr int NTHR = 512;
constexpr float EPS = 1e-6f;
constexpr int LDS_BYTES = 147456;

constexpr size_t MiB = 1u << 20;
constexpr size_t WS_WIN = 1 * MiB;
constexpr size_t WS_WOUT = 11 * MiB;
constexpr size_t WS_WFI = 15 * MiB;
constexpr size_t WS_WFO = 37 * MiB;
constexpr size_t WS_MOD = 48 * MiB;
constexpr size_t WS_PE = WS_MOD + 512 * 1024;
constexpr size_t WS_WLR = WS_PE + 128 * 1024;
constexpr size_t WS_DEC = WS_WLR + 256 * 1024;
constexpr size_t WS_DL = 50 * MiB;
constexpr size_t WS_DLC = 58 * MiB;
constexpr size_t WS_XC = 59 * MiB;
constexpr size_t WS_LR = 67 * MiB;
constexpr size_t WS_H = 70 * MiB;
constexpr size_t WS_PA = 106 * MiB;
constexpr size_t WS_PB = 160 * MiB;
constexpr size_t WS_YC = 196 * MiB;
constexpr size_t WS_ZT = 232 * MiB;
constexpr size_t WS_ZTC = 240 * MiB;
constexpr size_t WS_HID = 106 * MiB;
constexpr size_t WS_Y = 106 * MiB;
constexpr size_t WS_Y2 = 205 * MiB;
constexpr size_t WS_END = 241 * MiB;

struct Params { const float* in[21]; float* out; unsigned char* ws; };
typedef __attribute__((address_space(4))) const unsigned char kchar;
__device__ __forceinline__ kchar* kargs() { kchar* ka = (kchar*)__builtin_amdgcn_kernarg_segment_ptr(); asm volatile("" : "+s"(ka)); return ka; }
__device__ __forceinline__ const float* inp(int i) { return *(const float* __attribute__((address_space(4))) const*)(kargs() + 8 * i); }
__device__ __forceinline__ float* outp() { return *(float* __attribute__((address_space(4))) const*)(kargs() + 8 * 21); }
__device__ __forceinline__ unsigned char* wsp() { return *(unsigned char* __attribute__((address_space(4))) const*)(kargs() + 8 * 22); }

__device__ __forceinline__ float bf2f(unsigned short b) { return __uint_as_float(((unsigned)b) << 16); }
typedef __bf16 bf16x2_t __attribute__((ext_vector_type(2)));
__device__ __forceinline__ unsigned pkbf(float lo, float hi) { f32x2 v; v[0] = lo; v[1] = hi; const bf16x2_t b = __builtin_convertvector(v, bf16x2_t); return __builtin_bit_cast(unsigned, b); }
__device__ __forceinline__ unsigned short f2bf(float f) { return (unsigned short)(pkbf(f, 0.f) & 0xffffu); }
__device__ __forceinline__ float lo16(unsigned r) { return __uint_as_float(r << 16); }
__device__ __forceinline__ float hi16(unsigned r) { return __uint_as_float(r & 0xffff0000u); }
__device__ __forceinline__ float wave_sum(float v) {
#pragma unroll
    for (int o = 1; o < 64; o <<= 1) v += __shfl_xor(v, o);
    return v;
}
__device__ __forceinline__ float silu_f(float a) { return a / (1.f + __expf(-a)); }
__device__ __forceinline__ float logsig16(float z) { return (fminf(z, 0.f) - log1pf(expf(-fabsf(z)))) * (1.f / 16.f); }

struct EpiStore {
    static constexpr bool PERM = true, AFTER_DRAIN = false;
    bf16_t* O0; int ld0; bf16_t* O1; int ld1; int split;
    __device__ __forceinline__ void operator()(const pg8::f32x4 (&acc)[2][2][4][2], const pg8::Unit& u, int wr, int wc, int fr, int fq) const {
        const int row0 = u.pm * 256 + wr * 64 + fr;
        bf16_t* base; int ld, colt;
        if (u.pn < split) { base = O0; ld = ld0; colt = u.pn * 256; } else { base = O1; ld = ld1; colt = (u.pn - split) * 256; }
        const int col0 = colt + wc * 32 + 8 * fq;
#pragma unroll
        for (int ai = 0; ai < 2; ++ai)
#pragma unroll
            for (int m = 0; m < 4; ++m) { bf16_t* rowp = base + (size_t)(row0 + ai * 128 + m * 16) * ld + col0;
#pragma unroll
                for (int bj = 0; bj < 2; ++bj) { const pg8::f32x4 v0 = acc[ai][bj][m][0], v1 = acc[ai][bj][m][1];
                    u32x4 w; w.x = pkbf(v0[0], v0[1]); w.y = pkbf(v0[2], v0[3]); w.z = pkbf(v1[0], v1[1]); w.w = pkbf(v1[2], v1[3]);
                    *(u32x4*)(rowp + bj * 128) = w; } }
    }
};
struct EpiF2 {
    static constexpr bool PERM = true, AFTER_DRAIN = false;
    bf16_t* O; int L;
    __device__ __forceinline__ void operator()(const pg8::f32x4 (&acc)[2][2][4][2], const pg8::Unit& u, int wr, int wc, int fr, int fq) const {
        const int row0 = u.pn * L + u.pm * 256 + wr * 64 + fr;
        const int col0 = wc * 32 + 8 * fq;
#pragma unroll
        for (int ai = 0; ai < 2; ++ai)
#pragma unroll
            for (int m = 0; m < 4; ++m) { bf16_t* rowp = O + (size_t)(row0 + ai * 128 + m * 16) * D + col0;
#pragma unroll
                for (int bj = 0; bj < 2; ++bj) { const pg8::f32x4 v0 = acc[ai][bj][m][0], v1 = acc[ai][bj][m][1];
                    u32x4 w; w.x = pkbf(v0[0], v0[1]); w.y = pkbf(v0[2], v0[3]); w.z = pkbf(v1[0], v1[1]); w.w = pkbf(v1[2], v1[3]);
                    *(u32x4*)(rowp + bj * 128) = w; } }
    }
};
struct EpiSwiglu {
    static constexpr bool PERM = true, AFTER_DRAIN = false;
    bf16_t* O; int ld;
    __device__ __forceinline__ void operator()(const pg8::f32x4 (&acc)[2][2][4][2], const pg8::Unit& u, int wr, int wc, int fr, int fq) const {
        const int row0 = u.pm * 256 + wr * 64 + fr;
        const int col0 = u.pn * 128 + wc * 32 + 8 * fq;
#pragma unroll
        for (int ai = 0; ai < 2; ++ai)
#pragma unroll
            for (int m = 0; m < 4; ++m) { bf16_t* rowp = O + (size_t)(row0 + ai * 128 + m * 16) * ld + col0;
                const pg8::f32x4 a0 = acc[ai][0][m][0], a1 = acc[ai][0][m][1], u0 = acc[ai][1][m][0], u1 = acc[ai][1][m][1];
                u32x4 w;
                w.x = pkbf(silu_f(a0[0]) * u0[0], silu_f(a0[1]) * u0[1]); w.y = pkbf(silu_f(a0[2]) * u0[2], silu_f(a0[3]) * u0[3]);
                w.z = pkbf(silu_f(a1[0]) * u1[0], silu_f(a1[1]) * u1[1]); w.w = pkbf(silu_f(a1[2]) * u1[2], silu_f(a1[3]) * u1[3]);
                *(u32x4*)rowp = w; }
    }
};

__device__ __forceinline__ void transpose_item(const float* W, int K, int N, int k0, int n0, bf16_t* WT, int dst_row0, LAS float* scr, int lane) {
#pragma unroll 8
    for (int i = 0; i < 32; ++i) { const int kk = 2 * i + (lane >> 5); scr[kk * 33 + (lane & 31)] = W[(size_t)(k0 + kk) * N + n0 + (lane & 31)]; }
    asm volatile("s_waitcnt lgkmcnt(0)" ::: "memory");
    const int c = lane & 7;
#pragma unroll
    for (int j = 0; j < 4; ++j) { const int n = (lane >> 3) + 8 * j; const LAS float* s = scr + (8 * c) * 33 + n;
        u32x4 o; o.x = pkbf(s[0 * 33], s[1 * 33]); o.y = pkbf(s[2 * 33], s[3 * 33]); o.z = pkbf(s[4 * 33], s[5 * 33]); o.w = pkbf(s[6 * 33], s[7 * 33]);
        *(u32x4*)(WT + (size_t)(dst_row0 + n) * K + k0 + 8 * c) = o; }
    asm volatile("s_waitcnt lgkmcnt(0)" ::: "memory");
}

__device__ __forceinline__ void phase_prologue(const Params& p, LAS unsigned char* lds, int tid, int lane, int wave, int bid, int G) {
    unsigned char* ws = wsp();
    {
        LAS float* sc = (LAS float*)lds;
        LAS float* red = (LAS float*)(lds + 36864);
        float* MOD = (float*)(ws + WS_MOD);
        for (int it = bid; it < 48; it += G) {
            const int li = it / 24, jb = it % 24;
            for (int e = tid; e < 9 * 1024; e += NTHR) { const int r = e >> 10, k = e & 1023; const float cv = r < 8 ? inp(1)[r * 1024 + k] : inp(3)[k]; sc[e] = cv / (1.f + expf(-cv)); }
            __syncthreads();
            float acc[9][4];
#pragma unroll
            for (int r = 0; r < 9; ++r) { acc[r][0] = 0.f; acc[r][1] = 0.f; acc[r][2] = 0.f; acc[r][3] = 0.f; }
            const float* wm = inp(4) + ((size_t)li * 1024 + wave * 128) * 6144 + jb * 256 + lane * 4;
#pragma unroll 4
            for (int k = 0; k < 128; ++k) { const f32x4 wv = *(const f32x4*)(wm + (size_t)k * 6144);
#pragma unroll
                for (int r = 0; r < 9; ++r) { const float s = sc[r * 1024 + wave * 128 + k]; acc[r][0] += s * wv[0]; acc[r][1] += s * wv[1]; acc[r][2] += s * wv[2]; acc[r][3] += s * wv[3]; } }
#pragma unroll
            for (int r = 0; r < 9; ++r) { f32x4 o; o[0] = acc[r][0]; o[1] = acc[r][1]; o[2] = acc[r][2]; o[3] = acc[r][3]; *(LAS f32x4*)(red + ((wave * 9 + r) * 256 + lane * 4)) = o; }
            __syncthreads();
            for (int e = tid; e < 9 * 256; e += NTHR) { const int r = e >> 8, jj = e & 255; float s = inp(5)[li * 6144 + jb * 256 + jj];
#pragma unroll
                for (int w = 0; w < 8; ++w) s += red[(w * 9 + r) * 256 + jj];
                MOD[(size_t)(li * 9 + r) * 6144 + jb * 256 + jj] = s; }
            __syncthreads();
        }
    }
    {
        LAS float* scr = (LAS float*)(lds + wave * 16384);
        const int gw = bid * 8 + wave, NGW = G * 8;
        constexpr int I_IN = 16 * 81, I_OUT = 16 * 32, I_FI = 16 * 176, I_FO = 44 * 32, I_L = I_IN + I_OUT + I_FI + I_FO;
        bf16_t* Win_t = (bf16_t*)(ws + WS_WIN); bf16_t* Wout_t = (bf16_t*)(ws + WS_WOUT); bf16_t* Wfi_t = (bf16_t*)(ws + WS_WFI); bf16_t* Wfo_t = (bf16_t*)(ws + WS_WFO);
        float* WLR = (float*)(ws + WS_WLR);
        for (int it = gw; it < 2 * I_L; it += NGW) {
            const int li = it / I_L; int r = it % I_L;
            if (r < I_IN) { const int kb = r / 81, nb = r % 81, n0 = nb * 32, k0 = kb * 64; const float* W = inp(10) + (size_t)li * 1024 * INC;
                if (n0 == 768) {
#pragma unroll 8
                    for (int i = 0; i < 32; ++i) { const int kk = 2 * i + (lane >> 5); WLR[(size_t)(li * 1024 + k0 + kk) * 32 + (lane & 31)] = W[(size_t)(k0 + kk) * INC + 768 + (lane & 31)]; }
                } else transpose_item(W, 1024, INC, k0, n0, Win_t + (size_t)li * NP * 1024, n0 < 768 ? n0 : n0 - 32, scr, lane);
                continue; }
            r -= I_IN;
            if (r < I_OUT) { const int kb = r / 32, nb = r % 32; transpose_item(inp(18) + (size_t)li * 1024 * 1024, 1024, 1024, kb * 64, nb * 32, Wout_t + (size_t)li * 1024 * 1024, nb * 32, scr, lane); continue; }
            r -= I_OUT;
            if (r < I_FI) { const int kb = r / 176, nb = r % 176, n0 = nb * 32; const int j0 = n0 < FFH ? n0 : n0 - FFH; const int dst = 256 * (j0 / 128) + (j0 % 128) + (n0 < FFH ? 0 : 128);
                transpose_item(inp(19) + (size_t)li * 1024 * 2 * FFH, 1024, 2 * FFH, kb * 64, n0, Wfi_t + (size_t)li * 2 * FFH * 1024, dst, scr, lane); continue; }
            r -= I_FI;
            { const int kb = r / 32, nb = r % 32; transpose_item(inp(20) + (size_t)li * FFH * 1024, FFH, 1024, kb * 64, nb * 32, Wfo_t + (size_t)li * 1024 * FFH, nb * 32, scr, lane); }
        }
    }
    {
        const int gt = bid * NTHR + tid, NT = G * NTHR;
        float* PE = (float*)(ws + WS_PE);
        for (int e = gt; e < 64 * 512; e += NT) { const int pp = e >> 9, dd = e & 511, i = dd & 255; const float f = 1.0f / powf(10000.0f, (float)i / 256.0f); const float ang = (float)pp * f; PE[e] = dd < 256 ? sinf(ang) : cosf(ang); }
        bf16_t* DL = (bf16_t*)(ws + WS_DL);
        const float sL = 0.022097086912079608f;
        for (int it = gt; it < 2048 * 256; it += NT) { const int lp = it >> 8, k8 = (it & 255) * 8; float v[8];
#pragma unroll
            for (int j = 0; j < 8; ++j) { const int k = k8 + j; v[j] = (k <= 1024) ? cospif((float)((lp * k) & 2047) * (1.0f / 1024.0f)) * sL : -sinpif((float)((lp * (k - 1024)) & 2047) * (1.0f / 1024.0f)) * sL; }
            u32x4 o; o.x = pkbf(v[0], v[1]); o.y = pkbf(v[2], v[3]); o.z = pkbf(v[4], v[5]); o.w = pkbf(v[6], v[7]); *(u32x4*)(DL + (size_t)lp * 2048 + k8) = o; }
        bf16_t* DLC = (bf16_t*)(ws + WS_DLC);
        for (int it = gt; it < 256 * 32; it += NT) { const int lp = it >> 5, k8 = (it & 31) * 8; float v[8];
#pragma unroll
            for (int j = 0; j < 8; ++j) { const int k = k8 + j; v[j] = (k <= 128) ? cospif((float)((lp * k) & 255) * (1.0f / 128.0f)) * 0.0625f : -sinpif((float)((lp * (k - 128)) & 255) * (1.0f / 128.0f)) * 0.0625f; }
            u32x4 o; o.x = pkbf(v[0], v[1]); o.y = pkbf(v[2], v[3]); o.z = pkbf(v[4], v[5]); o.w = pkbf(v[6], v[7]); *(u32x4*)(DLC + (size_t)lp * 256 + k8) = o; }
    }
}

__device__ __forceinline__ void phase_rows(const Params& p, LAS unsigned char* lds, int tid, int lane, int wave, int bid, int G, int kind, int li) {
    unsigned char* ws = wsp();
    const bool need_h = !(kind == 2 && li == 1);
    const bool need_lr = need_h && kind != 1;
    const int lh = (kind == 1) ? li : (kind == 0 ? 0 : li + 1);
    const int nrows = (li == 1 && kind >= 1) ? MLAT : MTOT;
    LAS float* wl = (LAS float*)lds;
    const float* MOD = (const float*)(ws + WS_MOD);
    const float* PE = (const float*)(ws + WS_PE);
    float* XC = (float*)(ws + WS_XC);
    bf16_t* H = (bf16_t*)(ws + WS_H);
    float* LR = (float*)(ws + WS_LR);
    if (need_lr) {
        const float* WLR = (const float*)(ws + WS_WLR) + (size_t)lh * 1024 * 32;
        for (int e = tid; e < 32768; e += NTHR) { const int k = e >> 5, c = e & 31; wl[(k >> 1) * 68 + 2 * c + (k & 1)] = WLR[e]; }
        __syncthreads();
    }
    for (int r = bid * 8 + wave; r < nrows; r += G * 8) {
        const bool lat = r < MLAT;
        const int bidx = lat ? (r >> 11) : 8;
        const float* xin = (kind == 0) ? (lat ? inp(0) + (size_t)r * D : inp(2) + (size_t)(r - MLAT) * D) : (lat ? outp() + (size_t)r * D : XC + (size_t)(r - MLAT) * D);
        float* xout = lat ? outp() + (size_t)r * D : XC + (size_t)(r - MLAT) * D;
        float v[16];
#pragma unroll
        for (int j = 0; j < 8; ++j) { const f32x2 t2 = *(const f32x2*)(xin + 2 * lane + 128 * j); v[2 * j] = t2[0]; v[2 * j + 1] = t2[1]; }
        if (kind == 0 && lat) {
            const int t = r & 2047; const float* pa = PE + (t >> 6) * 512; const float* pb = PE + (t & 63) * 512;
#pragma unroll
            for (int j = 0; j < 8; ++j) { const int k = 2 * lane + 128 * j; const f32x2 e2 = (j < 4) ? *(const f32x2*)(pa + k) : *(const f32x2*)(pb + k - 512); v[2 * j] += e2[0]; v[2 * j + 1] += e2[1]; }
        }
        if (kind >= 1) {
            const bf16_t* yr = (const bf16_t*)(ws + (kind == 1 ? WS_Y : WS_Y2)) + (size_t)r * D;
            float yv[16]; float ss = 0.f;
#pragma unroll
            for (int j = 0; j < 8; ++j) { const unsigned raw = *(const unsigned*)(yr + 2 * lane + 128 * j); yv[2 * j] = lo16(raw); yv[2 * j + 1] = hi16(raw); ss += yv[2 * j] * yv[2 * j] + yv[2 * j + 1] * yv[2 * j + 1]; }
            ss = wave_sum(ss); const float rs = rsqrtf(ss * (1.0f / 1024.0f) + EPS);
            const float* gate = MOD + (size_t)(li * 9 + bidx) * 6144 + (kind == 1 ? 2 : 5) * 1024;
            const float* gp = inp(kind == 1 ? 7 : 9) + li * 1024;
#pragma unroll
            for (int j = 0; j < 8; ++j) { const int k = 2 * lane + 128 * j; const f32x2 g2 = *(const f32x2*)(gate + k), q2 = *(const f32x2*)(gp + k);
                v[2 * j] += g2[0] * ((yv[2 * j] * rs) * q2[0]); v[2 * j + 1] += g2[1] * ((yv[2 * j + 1] * rs) * q2[1]); }
        }
#pragma unroll
        for (int j = 0; j < 8; ++j) { f32x2 o; o[0] = v[2 * j]; o[1] = v[2 * j + 1]; *(f32x2*)(xout + 2 * lane + 128 * j) = o; }
        if (need_h) {
            float ss2 = 0.f;
#pragma unroll
            for (int j = 0; j < 16; ++j) ss2 += v[j] * v[j];
            ss2 = wave_sum(ss2); const float rs2 = rsqrtf(ss2 * (1.0f / 1024.0f) + EPS);
            const float* gpre = inp(kind == 1 ? 8 : 6) + lh * 1024;
            const float* md = MOD + (size_t)(lh * 9 + bidx) * 6144 + (kind == 1 ? 3 * 1024 : 0);
            float hv[16];
#pragma unroll
            for (int j = 0; j < 8; ++j) { const int k = 2 * lane + 128 * j; const f32x2 g2 = *(const f32x2*)(gpre + k), sh = *(const f32x2*)(md + k), sc = *(const f32x2*)(md + 1024 + k);
                hv[2 * j] = ((v[2 * j] * rs2) * g2[0]) * (1.f + sc[0]) + sh[0]; hv[2 * j + 1] = ((v[2 * j + 1] * rs2) * g2[1]) * (1.f + sc[1]) + sh[1];
                *(unsigned*)(H + (size_t)r * D + k) = pkbf(hv[2 * j], hv[2 * j + 1]); }
            if (need_lr) {
                float acc[32];
#pragma unroll
                for (int c = 0; c < 32; ++c) acc[c] = 0.f;
#pragma unroll
                for (int j = 0; j < 8; ++j) {
                    const LAS f32x4* wp;
                    { LAS float* bp = wl + (lane + 256 * (j >> 2)) * 68; asm volatile("" : "+v"(bp)); wp = (const LAS f32x4*)(bp + 64 * 68 * (j & 3)); }
                    const float h0 = hv[2 * j], h1 = hv[2 * j + 1];
#pragma unroll
                    for (int q = 0; q < 16; ++q) { const f32x4 w4 = wp[q]; acc[2 * q] += h0 * w4[0] + h1 * w4[1]; acc[2 * q + 1] += h0 * w4[2] + h1 * w4[3];
                        if ((q & 7) == 7) __builtin_amdgcn_sched_barrier(0); } }
                float a16[16], a8[8], a4[4], a2[2];
                { const bool up = (lane & 32) != 0;
#pragma unroll
                  for (int c = 0; c < 16; ++c) { const float keep = up ? acc[c + 16] : acc[c], send = up ? acc[c] : acc[c + 16]; a16[c] = keep + __shfl_xor(send, 32); } }
                { const bool up = (lane & 16) != 0;
#pragma unroll
                  for (int c = 0; c < 8; ++c) { const float keep = up ? a16[c + 8] : a16[c], send = up ? a16[c] : a16[c + 8]; a8[c] = keep + __shfl_xor(send, 16); } }
                { const bool up = (lane & 8) != 0;
#pragma unroll
                  for (int c = 0; c < 4; ++c) { const float keep = up ? a8[c + 4] : a8[c], send = up ? a8[c] : a8[c + 4]; a4[c] = keep + __shfl_xor(send, 8); } }
                { const bool up = (lane & 4) != 0;
#pragma unroll
                  for (int c = 0; c < 2; ++c) { const float keep = up ? a4[c + 2] : a4[c], send = up ? a4[c] : a4[c + 2]; a2[c] = keep + __shfl_xor(send, 4); } }
                float a1;
                { const bool up = (lane & 2) != 0; const float keep = up ? a2[1] : a2[0], send = up ? a2[0] : a2[1]; a1 = keep + __shfl_xor(send, 2); }
                a1 += __shfl_xor(a1, 1);
                if ((lane & 1) == 0) LR[(size_t)r * 32 + (lane >> 1)] = a1;
            }
        }
    }
}

__device__ __forceinline__ void f1_item(const Params& p, LAS unsigned char* lds, int tid, int lane, int wave, int it) {
    unsigned char* ws = wsp();
    const bf16_t* PB = (const bf16_t*)(ws + WS_PB);
    int b, tb, L, seqbase; bf16_t* ZT;
    if (it < 128) { b = it >> 4; tb = it & 15; L = SEQ; seqbase = b * SEQ; ZT = (bf16_t*)(ws + WS_ZT); }
    else { const int ic = it - 128; b = ic >> 1; tb = ic & 1; L = CTXL; seqbase = MLAT + b * CTXL; ZT = (bf16_t*)(ws + WS_ZTC); }
    const int Lh = L >> 1;
    LAS bf16_t* ue_s = (LAS bf16_t*)(lds);
    LAS bf16_t* uo_s = (LAS bf16_t*)(lds + 33792);
    LAS bf16_t* cc_s = (LAS bf16_t*)(lds + 67584);
    LAS bf16_t* sc_s = (LAS bf16_t*)(lds + 76800);
    LAS float* sp_s = (LAS float*)(lds + 86016);
#pragma unroll
    for (int q = 0; q < 4; ++q) {
        const int e = tid + NTHR * q, t = e >> 5, c8 = e & 31, l = 64 * tb + t;
        const u32x4 a = *(const u32x4*)(PB + (size_t)(seqbase + l) * NPB + c8 * 8);
        u32x4 m = (u32x4){0u, 0u, 0u, 0u};
        if (l > 0) m = *(const u32x4*)(PB + (size_t)(seqbase + L - l) * NPB + c8 * 8);
        u32x4 se, so;
#pragma unroll
        for (int w = 0; w < 4; ++w) { const float a0 = lo16(a[w]), a1 = hi16(a[w]), m0 = lo16(m[w]), m1 = hi16(m[w]);
            se[w] = pkbf(a0 + m0, a1 + m1); so[w] = (l > 0) ? pkbf(a0 - m0, a1 - m1) : 0u; }
        *(LAS u32x4*)(ue_s + t * 264 + c8 * 8) = se; *(LAS u32x4*)(uo_s + t * 264 + c8 * 8) = so;
    }
    if (tb == 0 && tid < 256) sp_s[tid] = bf2f(PB[(size_t)(seqbase + Lh) * NPB + tid]);
    __syncthreads();
    const int fr = lane & 15, fq = lane >> 4;
    const int g = wave >> 1, typ = wave & 1;
    const LAS bf16_t* src = typ ? uo_s : ue_s; const LAS bf16_t* mat = typ ? sc_s : cc_s;
#pragma unroll
    for (int lt = 0; lt < 4; ++lt) {
        bf16x8 a0 = *(const LAS bf16x8*)(src + (16 * lt + fr) * 264 + 64 * g + 8 * fq), a1 = *(const LAS bf16x8*)(src + (16 * lt + fr) * 264 + 64 * g + 32 + 8 * fq);
#pragma unroll
        for (int ct = 0; ct < 4; ++ct) {
            const bf16x8 b0 = *(const LAS bf16x8*)(mat + (16 * ct + fr) * 72 + 8 * fq), b1 = *(const LAS bf16x8*)(mat + (16 * ct + fr) * 72 + 32 + 8 * fq);
            f32x4 acc = (f32x4){0.f, 0.f, 0.f, 0.f};
            acc = __builtin_amdgcn_mfma_f32_16x16x32_bf16(a0, b0, acc, 0, 0, 0);
            acc = __builtin_amdgcn_mfma_f32_16x16x32_bf16(a1, b1, acc, 0, 0, 0);
            if (typ == 1 && tb == 0 && lt == 0 && fq == 0) {
                float s = 0.f;
                for (int c = 0; c < 64; ++c) s += sp_s[64 * g + c] * bf2f(cc_s[(16 * ct + fr) * 72 + c]);
                acc[0] = s;
            }
            const int n = b * 256 + g * 64 + 16 * ct + fr, kidx = typ * Lh + 64 * tb + 16 * lt + 4 * fq;
            u32x2 o; o[0] = pkbf(acc[0], acc[1]); o[1] = pkbf(acc[2], acc[3]);
            *(u32x2*)(ZT + (size_t)n * L + kidx) = o;
        }
    }
    __syncthreads();
}

__device__ __forceinline__ float logsig_z(const LAS float* lrow, const float (&wd)[16], float bd) {
    const LAS f32x4* lp = (const LAS f32x4*)lrow; float z = bd;
#pragma unroll
    for (int q = 0; q < 4; ++q) { const f32x4 l4 = lp[q]; z += l4[0] * wd[4 * q] + l4[1] * wd[4 * q + 1] + l4[2] * wd[4 * q + 2] + l4[3] * wd[4 * q + 3]; }
    return logsig16(z);
}

__device__ __forceinline__ void g1_item(const Params& p, LAS unsigned char* lds, int tid, int lane, int wave, int li, int it) {
    unsigned char* ws = wsp();
    const int dir = it & 1, h = (it >> 1) & 3, bc = it >> 3, cidx = bc % NCH, b = bc / NCH;
    const int row0 = cidx < 4 ? MLAT + b * CTXL + cidx * 64 : b * SEQ + (cidx - 4) * 64;
    const int unit = (b * 4 + h) * 2 + dir;
    LAS float* lr_s = (LAS float*)(lds);
    LAS float* wd_s = (LAS float*)(lds + 4096);
    LAS float* seg_s = (LAS float*)(lds + 8192);
    LAS bf16_t* ku_s = (LAS bf16_t*)(lds + 10240);
    LAS bf16_t* v_s = (LAS bf16_t*)(lds + 19456);
    const bf16_t* PA = (const bf16_t*)(ws + WS_PA);
    const float* LR = (const float*)(ws + WS_LR);
    const float* wdec = inp(dir ? 13 : 11) + li * 16 * 256; const float* bdec = inp(dir ? 14 : 12) + li * 256;
    const int d = tid & 63, tg = wave;
#pragma unroll
    for (int q = 0; q < 2; ++q) { const int e = tid + NTHR * q; const int t = e >> 4, rr = e & 15; lr_s[e] = LR[(size_t)(row0 + t) * 32 + dir * 16 + rr];
        wd_s[e] = wdec[(e >> 6) * 256 + h * 64 + (e & 63)];
        *(LAS u32x4*)(v_s + t * 136 + rr * 8) = *(const u32x4*)(PA + (size_t)(row0 + t) * NPA + 256 + h * 128 + rr * 8); }
    float kk[8];
#pragma unroll
    for (int i = 0; i < 8; ++i) kk[i] = bf2f(PA[(size_t)(row0 + 8 * tg + i) * NPA + h * 64 + d]);
    const float bd = bdec[h * 64 + d];
    __syncthreads();
    float wd[16];
#pragma unroll
    for (int r = 0; r < 16; ++r) wd[r] = wd_s[r * 64 + d];
    float c[8];
#pragma unroll
    for (int i = 0; i < 8; ++i) c[i] = logsig_z(lr_s + (8 * tg + i) * 16, wd, bd);
    if (dir == 0) {
#pragma unroll
        for (int i = 1; i < 8; ++i) c[i] += c[i - 1];
    } else {
#pragma unroll
        for (int i = 6; i >= 0; --i) c[i] += c[i + 1];
    }
    seg_s[tg * 64 + d] = dir == 0 ? c[7] : c[0];
    __syncthreads();
    float off = 0.f, tot = 0.f;
#pragma unroll
    for (int g = 0; g < 8; ++g) { const float s = seg_s[g * 64 + d]; tot += s; if (dir == 0 ? (g < tg) : (g > tg)) off += s; }
    const float base = tot - off;
    u32x4 pk;
    pk[0] = pkbf(kk[0] * __expf(base - c[0]), kk[1] * __expf(base - c[1])); pk[1] = pkbf(kk[2] * __expf(base - c[2]), kk[3] * __expf(base - c[3]));
    pk[2] = pkbf(kk[4] * __expf(base - c[4]), kk[5] * __expf(base - c[5])); pk[3] = pkbf(kk[6] * __expf(base - c[6]), kk[7] * __expf(base - c[7]));
    *(LAS u32x4*)(ku_s + d * 72 + 8 * tg) = pk;
    if (tg == 0) ((float*)(ws + WS_DEC))[(size_t)(unit * NCH + cidx) * 64 + d] = __expf(tot);
    __syncthreads();
    const int fr = lane & 15, fq = lane >> 4;
    bf16x8 vb[2];
#pragma unroll
    for (int ks = 0; ks < 2; ++ks)
#pragma unroll
        for (int j = 0; j < 8; ++j) vb[ks][j] = (short)v_s[(32 * ks + 8 * fq + j) * 136 + 16 * wave + fr];
    bf16_t* dso = (bf16_t*)(ws + WS_H) + ((size_t)(unit * NCH + cidx) * 128 + 16 * wave + fr) * 64 + 4 * fq;
#pragma unroll
    for (int dt = 0; dt < 4; ++dt) {
        f32x4 acc = (f32x4){0.f, 0.f, 0.f, 0.f};
#pragma unroll
        for (int ks = 0; ks < 2; ++ks) { const bf16x8 a = *(const LAS bf16x8*)(ku_s + (16 * dt + fr) * 72 + 32 * ks + 8 * fq); acc = __builtin_amdgcn_mfma_f32_16x16x32_bf16(a, vb[ks], acc, 0, 0, 0); }
        u32x2 o; o[0] = pkbf(acc[0], acc[1]); o[1] = pkbf(acc[2], acc[3]);
        *(u32x2*)(dso + 16 * dt) = o;
    }
    __syncthreads();
}

__device__ __forceinline__ void phase_x1(const Params& p, LAS unsigned char* lds, int tid, int lane, int wave, int bid, int G, int li) {
    unsigned char* ws = wsp();
#ifndef DBG_X1
#define DBG_X1 7
#endif
    if (DBG_X1 & 1) {
        LAS bf16_t* cc_s = (LAS bf16_t*)(lds + 67584); LAS bf16_t* sc_s = (LAS bf16_t*)(lds + 76800);
        for (int e = tid; e < 4096; e += NTHR) { const int cp = e >> 6, c = e & 63; const float x = (float)((cp * c) & 63) * (1.0f / 32.0f); cc_s[cp * 72 + c] = f2bf(cospif(x) * 0.125f); sc_s[cp * 72 + c] = f2bf(sinpif(x) * 0.125f); }
        __syncthreads();
        const int nF1 = li == 0 ? 144 : 128;
        for (int it = bid; it < nF1; it += G) f1_item(p, lds, tid, lane, wave, it);
    }
    if (DBG_X1 & 2) {
        const bf16_t* PB = (const bf16_t*)(ws + WS_PB); bf16_t* YC = (bf16_t*)(ws + WS_YC);
        const float* cw = inp(16) + li * 3 * 256; const float* cb = inp(17) + li * 256;
        const int nrows = li == 0 ? MTOT : MLAT;
        for (int it = bid * NTHR + tid; it < nrows * 32; it += G * NTHR) {
            const int r = it >> 5, c8 = it & 31;
            const int t = r < MLAT ? (r & 2047) : ((r - MLAT) & 255); const int L = r < MLAT ? SEQ : CTXL;
            const bf16_t* row = PB + (size_t)r * NPB + c8 * 8;
            const u32x4 bg = *(const u32x4*)(row + 256), c0 = *(const u32x4*)(row + 512), u0 = *(const u32x4*)(row + 768);
            u32x4 cm = (u32x4){0u, 0u, 0u, 0u}, um = cm, cp = cm, up = cm;
            if (t > 0) { cm = *(const u32x4*)(row - NPB + 512); um = *(const u32x4*)(row - NPB + 768); }
            if (t < L - 1) { cp = *(const u32x4*)(row + NPB + 512); up = *(const u32x4*)(row + NPB + 768); }
            u32x4 o;
#pragma unroll
            for (int w = 0; w < 4; ++w) {
                const int ch = c8 * 8 + 2 * w;
                const float zl0 = lo16(cm[w]) * lo16(um[w]), zl1 = hi16(cm[w]) * hi16(um[w]);
                const float zc0 = lo16(c0[w]) * lo16(u0[w]), zc1 = hi16(c0[w]) * hi16(u0[w]);
                const float zr0 = lo16(cp[w]) * lo16(up[w]), zr1 = hi16(cp[w]) * hi16(up[w]);
                const float y0 = cw[ch] * zl0 + cw[256 + ch] * zc0 + cw[512 + ch] * zr0 + cb[ch];
                const float y1 = cw[ch + 1] * zl1 + cw[256 + ch + 1] * zc1 + cw[512 + ch + 1] * zr1 + cb[ch + 1];
                o[w] = pkbf(lo16(bg[w]) * y0, hi16(bg[w]) * y1);
            }
            *(u32x4*)(YC + (size_t)r * D + 768 + c8 * 8) = o;
        }
    }
    if (DBG_X1 & 4) for (int it = bid; it < NB * NCH * 8; it += G) g1_item(p, lds, tid, lane, wave, li, it);
}

__device__ __forceinline__ void scan_states(const Params& p, int tix0, int tstride) {
    unsigned char* ws = wsp();
    const bf16_t* DS = (const bf16_t*)(ws + WS_H); bf16_t* S = (bf16_t*)(ws + WS_PB); const float* DEC = (const float*)(ws + WS_DEC);
    for (int tix = tix0; tix < 64 * 128 * 8; tix += tstride) {
        const int unit = tix >> 10, v = (tix >> 3) & 127, dg = tix & 7, dir = unit & 1;
        float s[8];
#pragma unroll
        for (int j = 0; j < 8; ++j) s[j] = 0.f;
#pragma unroll 4
        for (int step = 0; step < NCH; ++step) {
            const int cidx = dir == 0 ? step : (step < 4 ? 3 - step : 39 - step);
            const size_t a = ((size_t)(unit * NCH + cidx) * 128 + v) * 64 + dg * 8;
            const u32x4 dsv = *(const u32x4*)(DS + a);
            const f32x4 d0 = *(const f32x4*)(DEC + (size_t)(unit * NCH + cidx) * 64 + dg * 8), d1 = *(const f32x4*)(DEC + (size_t)(unit * NCH + cidx) * 64 + dg * 8 + 4);
            u32x4 o; o[0] = pkbf(s[0], s[1]); o[1] = pkbf(s[2], s[3]); o[2] = pkbf(s[4], s[5]); o[3] = pkbf(s[6], s[7]);
            *(u32x4*)(S + a) = o;
            s[0] = d0[0] * s[0] + lo16(dsv[0]); s[1] = d0[1] * s[1] + hi16(dsv[0]); s[2] = d0[2] * s[2] + lo16(dsv[1]); s[3] = d0[3] * s[3] + hi16(dsv[1]);
            s[4] = d1[0] * s[4] + lo16(dsv[2]); s[5] = d1[1] * s[5] + hi16(dsv[2]); s[6] = d1[2] * s[6] + lo16(dsv[3]); s[7] = d1[3] * s[7] + hi16(dsv[3]);
        }
    }
}

__device__ __forceinline__ void g3_item(const Params& p, LAS unsigned char* lds, int tid, int lane, int wave, int li, int b, int cidx, int h) {
    unsigned char* ws = wsp();
    const int row0 = cidx < 4 ? MLAT + b * CTXL + cidx * 64 : b * SEQ + (cidx - 4) * 64;
    LAS float* lr_s = (LAS float*)(lds);
    LAS float* wd_s = (LAS float*)(lds + 8192);
    LAS float* seg_s = (LAS float*)(lds + 16384);
    LAS float* gm_s = (LAS float*)(lds + 18432);
    LAS float* ssq_s = (LAS float*)(lds + 18688);
    LAS bf16_t* v_s = (LAS bf16_t*)(lds + 20736);
    LAS bf16_t* qt_s = (LAS bf16_t*)(lds + 38144);
    LAS bf16_t* kt_s = (LAS bf16_t*)(lds + 47360);
    LAS bf16_t* ao_s = (LAS bf16_t*)(lds + 56576);
    const bf16_t* PA = (const bf16_t*)(ws + WS_PA);
    const float* LR = (const float*)(ws + WS_LR);
    const bf16_t* S = (const bf16_t*)(ws + WS_PB);
    const int d = tid & 63, tg = wave, fr = lane & 15, fq = lane >> 4;
#pragma unroll
    for (int q = 0; q < 4; ++q) { const int e = tid + NTHR * q; lr_s[e] = LR[(size_t)(row0 + (e >> 5)) * 32 + (e & 31)];
        const int e1 = e & 1023; wd_s[e] = inp((e >> 10) ? 13 : 11)[li * 4096 + (e1 >> 6) * 256 + h * 64 + (e1 & 63)]; }
#pragma unroll
    for (int q = 0; q < 2; ++q) { const int e = tid + NTHR * q; const int t = e >> 4, rr = e & 15;
        *(LAS u32x4*)(v_s + t * 136 + rr * 8) = *(const u32x4*)(PA + (size_t)(row0 + t) * NPA + 256 + h * 128 + rr * 8); }
    float kk[8], qq[8];
#pragma unroll
    for (int i = 0; i < 8; ++i) { const bf16_t* rp = PA + (size_t)(row0 + 8 * tg + i) * NPA + h * 64 + d; kk[i] = bf2f(rp[0]); qq[i] = bf2f(rp[768]) * 0.125f; }
    __syncthreads();
    bf16x8 vb[2];
#pragma unroll
    for (int ks = 0; ks < 2; ++ks)
#pragma unroll
        for (int j = 0; j < 8; ++j) vb[ks][j] = (short)v_s[(32 * ks + 8 * fq + j) * 136 + 16 * wave + fr];
    f32x4 oacc[4];
#pragma unroll
    for (int i = 0; i < 4; ++i) oacc[i] = (f32x4){0.f, 0.f, 0.f, 0.f};
#pragma unroll 1
    for (int dir = 0; dir < 2; ++dir) {
        const int unit = (b * 4 + h) * 2 + dir;
        const bf16_t* Sp = S + ((size_t)(unit * NCH + cidx) * 128 + 16 * wave + fr) * 64 + 8 * fq;
        const bf16x8 sf0 = *(const bf16x8*)(Sp), sf1 = *(const bf16x8*)(Sp + 32);
        const float bd = inp(dir ? 14 : 12)[li * 256 + h * 64 + d];
        float wd[16];
#pragma unroll
        for (int r = 0; r < 16; ++r) wd[r] = wd_s[dir * 1024 + r * 64 + d];
        float c[8];
#pragma unroll
        for (int i = 0; i < 8; ++i) c[i] = logsig_z(lr_s + (8 * tg + i) * 32 + dir * 16, wd, bd);
        if (dir == 0) {
#pragma unroll
            for (int i = 1; i < 8; ++i) c[i] += c[i - 1];
        } else {
#pragma unroll
            for (int i = 6; i >= 0; --i) c[i] += c[i + 1];
        }
        seg_s[tg * 64 + d] = dir == 0 ? c[7] : c[0];
        __syncthreads();
        float off = 0.f;
#pragma unroll
        for (int g = 0; g < 8; ++g) { const float s = seg_s[g * 64 + d]; if (dir == 0 ? (g < tg) : (g > tg)) off += s; }
#pragma unroll
        for (int i = 0; i < 8; ++i) c[i] += off;
        if (dir == 0 ? (tg == 3) : (tg == 4)) gm_s[d] = dir == 0 ? c[7] : c[0];
        __syncthreads();
        const float gm = gm_s[d];
#pragma unroll
        for (int i = 0; i < 8; ++i) { const int t = 8 * tg + i;
            qt_s[t * 72 + d] = f2bf(qq[i] * __expf(c[i] - gm)); kt_s[t * 72 + d] = f2bf(kk[i] * __expf(gm - c[i])); ao_s[t * 136 + 64 + d] = f2bf(qq[i] * __expf(c[i])); }
        __syncthreads();
        {
            const int it = wave >> 1;
            const bf16x8 a0 = *(const LAS bf16x8*)(qt_s + (16 * it + fr) * 72 + 8 * fq), a1 = *(const LAS bf16x8*)(qt_s + (16 * it + fr) * 72 + 32 + 8 * fq);
#pragma unroll
            for (int jj = 0; jj < 2; ++jj) { const int jt = 2 * (wave & 1) + jj;
                const bf16x8 b0 = *(const LAS bf16x8*)(kt_s + (16 * jt + fr) * 72 + 8 * fq), b1 = *(const LAS bf16x8*)(kt_s + (16 * jt + fr) * 72 + 32 + 8 * fq);
                f32x4 acc = (f32x4){0.f, 0.f, 0.f, 0.f};
                acc = __builtin_amdgcn_mfma_f32_16x16x32_bf16(a0, b0, acc, 0, 0, 0);
                acc = __builtin_amdgcn_mfma_f32_16x16x32_bf16(a1, b1, acc, 0, 0, 0);
#pragma unroll
                for (int ii = 0; ii < 4; ++ii) { const int ir = 16 * it + 4 * fq + ii, jc = 16 * jt + fr; const bool keep = dir == 0 ? (jc <= ir) : (jc >= ir);
                    ao_s[ir * 136 + jc] = f2bf(keep ? acc[ii] : 0.f); } }
        }
        __syncthreads();
#pragma unroll
        for (int it = 0; it < 4; ++it) {
            const LAS bf16_t* ap = ao_s + (16 * it + fr) * 136 + 8 * fq;
            oacc[it] = __builtin_amdgcn_mfma_f32_16x16x32_bf16(*(const LAS bf16x8*)(ap), vb[0], oacc[it], 0, 0, 0);
            oacc[it] = __builtin_amdgcn_mfma_f32_16x16x32_bf16(*(const LAS bf16x8*)(ap + 32), vb[1], oacc[it], 0, 0, 0);
            oacc[it] = __builtin_amdgcn_mfma_f32_16x16x32_bf16(*(const LAS bf16x8*)(ap + 64), sf0, oacc[it], 0, 0, 0);
            oacc[it] = __builtin_amdgcn_mfma_f32_16x16x32_bf16(*(const LAS bf16x8*)(ap + 96), sf1, oacc[it], 0, 0, 0);
        }
        __syncthreads();
    }
#pragma unroll
    for (int it = 0; it < 4; ++it)
#pragma unroll
        for (int ii = 0; ii < 4; ++ii) { float sq = oacc[it][ii] * oacc[it][ii];
            sq += __shfl_xor(sq, 1); sq += __shfl_xor(sq, 2); sq += __shfl_xor(sq, 4); sq += __shfl_xor(sq, 8);
            if (fr == 0) ssq_s[wave * 64 + 16 * it + 4 * fq + ii] = sq; }
    __syncthreads();
    const int vcol = h * 128 + 16 * wave + fr;
    const float gn = inp(15)[li * 512 + vcol];
    bf16_t* YC = (bf16_t*)(ws + WS_YC);
#pragma unroll
    for (int it = 0; it < 4; ++it)
#pragma unroll
        for (int ii = 0; ii < 4; ++ii) { const int i = 16 * it + 4 * fq + ii; float tot = 0.f;
#pragma unroll
            for (int w = 0; w < 8; ++w) tot += ssq_s[w * 64 + i];
            const float rs = rsqrtf(tot * (1.0f / 128.0f) + EPS);
            const float rv = bf2f(PA[(size_t)(row0 + i) * NPA + 1024 + vcol]);
            YC[(size_t)(row0 + i) * D + vcol] = f2bf(((oacc[it][ii] * rs) * gn) * silu_f(rv)); }
    __syncthreads();
}


#ifndef DBG_STOP
#define DBG_STOP 99
#endif
__device__ __forceinline__ void dbg_digest() {
    const int bid = blockIdx.x, tid = threadIdx.x, G = gridDim.x;
    const unsigned* w = (const unsigned*)wsp(); unsigned* o = (unsigned*)outp();
    const size_t NW = WS_END / 4, NO = (size_t)MLAT * D;
    for (size_t i = (size_t)bid * NTHR + tid; i < NO; i += (size_t)G * NTHR) {
        unsigned x = o[i];
        for (size_t j = i; j < NW; j += NO) x ^= w[j];
        ((float*)o)[i] = (float)((x ^ (x >> 16)) & 0xFFFFu);
    }
}
#define DBG_CHECK(k) do { if (DBG_STOP == (k)) { GRID_SYNC_CG(); FRESH(); dbg_digest(); return; } } while (0)

#define RLX_AGENT __ATOMIC_RELAXED, __HIP_MEMORY_SCOPE_AGENT
#define XB_TMO      128
#define XB_XCNT(j)  (256  + 64 * (j))
#define XB_XSUB(j)  (1280 + 64 * (j))
#define XB_XGEN(j)  (2304 + 64 * (j))
#define XB_TOP      3328
#define XB_TOPGEN   3392
#define XCD_BAR_WORDS 3456
#define XB_SPIN_CAP (1u << 18)

__device__ __forceinline__ unsigned xb_ld(unsigned* p)              { return __hip_atomic_load(p, __ATOMIC_RELAXED, __HIP_MEMORY_SCOPE_AGENT); }
__device__ __forceinline__ unsigned xb_add(unsigned* p, unsigned v) { return __hip_atomic_fetch_add(p, v, __ATOMIC_RELAXED, __HIP_MEMORY_SCOPE_AGENT); }
__device__ __forceinline__ unsigned xb_xcc_id() { return (unsigned)__builtin_amdgcn_s_getreg((3 << 11) | 20) & 0xFu; }
#define XB_SPIN(cond, bar) do { unsigned _sp = 0; while (cond) { __builtin_amdgcn_s_sleep(1); \
    if ((++_sp & 255u) == 0u) { if (xb_ld(&(bar)[XB_TMO])) break; if (_sp > XB_SPIN_CAP) { atomicAdd(&(bar)[XB_TMO], 1u); break; } } } } while (0)

struct XcdBarrier {
    unsigned* bar; unsigned x;
    volatile LAS unsigned* st;
};

__device__ __forceinline__ XcdBarrier xcd_barrier_post(unsigned* bar, volatile LAS unsigned* st) {
    XcdBarrier b; b.bar = bar; b.x = xb_xcc_id(); b.st = st;
    if (threadIdx.x == 0) (void)xb_add(&bar[XB_XCNT(b.x)], 1u);
    return b;
}
__device__ __forceinline__ void xcd_barrier_complete(unsigned* bar, unsigned x, unsigned& nloc, unsigned& nx) {
    const unsigned G = gridDim.x * gridDim.y * gridDim.z;
    unsigned sum, cnt, mine, sp = 0u;
    for (;;) {
        sum = 0u; cnt = 0u; mine = 0u;
#pragma unroll
        for (unsigned j = 0; j < 16; ++j) { const unsigned c = xb_ld(&bar[XB_XCNT(j)]); sum += c; cnt += (c > 0u) ? 1u : 0u; mine = (j == x) ? c : mine; }
        if (sum == G) break;
        __builtin_amdgcn_s_sleep(1);
        if ((++sp & 255u) == 0u) { if (xb_ld(&bar[XB_TMO])) break; if (sp > XB_SPIN_CAP) { atomicAdd(&bar[XB_TMO], 1u); break; } }
    }
    nloc = mine > 0u ? mine : 1u; nx = cnt > 0u ? cnt : 1u;
}

__device__ __forceinline__ void xcd_barrier(const XcdBarrier& b) {
    asm volatile("s_waitcnt vmcnt(0)" ::: "memory");
    __syncthreads();
    if (threadIdx.x == 0) {
        unsigned* bar = b.bar;
        __builtin_amdgcn_s_waitcnt(0);
        unsigned nloc = b.st[0], nx = b.st[1];
        if (nloc == 0u) { xcd_barrier_complete(bar, b.x, nloc, nx); b.st[0] = nloc; b.st[1] = nx; }
        const unsigned old = xb_add(&bar[XB_XSUB(b.x)], 1u);
        const unsigned gen = old / nloc;
        if (old + 1u == (gen + 1u) * nloc) {
            __builtin_amdgcn_fence(__ATOMIC_RELEASE, "agent");
            asm volatile("s_waitcnt vmcnt(0)" ::: "memory");
            const unsigned og = xb_add(&bar[XB_TOP], 1u);
            const unsigned tg = og / nx;
            if (og + 1u == (tg + 1u) * nx) xb_add(&bar[XB_TOPGEN], 1u);
            else XB_SPIN(xb_ld(&bar[XB_TOPGEN]) == tg, bar);
            __builtin_amdgcn_fence(__ATOMIC_ACQUIRE, "agent");
            xb_add(&bar[XB_XGEN(b.x)], 1u);
            asm volatile("s_waitcnt vmcnt(0)" ::: "memory");
        } else {
            XB_SPIN(xb_ld(&bar[XB_XGEN(b.x)]) == gen, bar);
            __builtin_amdgcn_fence(__ATOMIC_ACQUIRE, "agent");
            asm volatile("s_waitcnt vmcnt(0)" ::: "memory");
        }
    }
    __syncthreads();
}


#ifndef REP_SYNC
#define REP_SYNC 1
#endif
#ifndef REP_GEMM
#define REP_GEMM 1
#endif
#ifndef REP_X13
#define REP_X13 1
#endif
#ifndef REP_X2
#define REP_X2 1
#endif
#ifndef REP_PRO
#define REP_PRO 1
#endif
#ifndef REP_R0
#define REP_R0 1
#endif
#define REPEAT(n) _Pragma("unroll 1") for (int rep_ = 0; rep_ < (n); ++rep_)
#define GEMM_CALL(EPI, g, S, E) REPEAT(REP_GEMM) pg8::gemm_phase<EPI, pg8::StaticOrder, true, true>(lds, g, S, E)

__global__ void __launch_bounds__(NTHR, 2) hybrid_fwd(Params p) {
    extern __shared__ __attribute__((aligned(16))) unsigned char lds_raw[];
    LAS unsigned char* lds = (LAS unsigned char*)lds_raw;
    cg::grid_group grid = cg::this_grid();
    int tid, lane, wave, bid; const int G = gridDim.x;
    unsigned char* ws; bf16_t *H, *PA, *PB, *YC;
#define FRESH() do { int t_ = threadIdx.x; asm volatile("" : "+v"(t_)); tid = t_; lane = tid & 63; wave = __builtin_amdgcn_readfirstlane(tid >> 6); int b_ = blockIdx.x; asm volatile("" : "+s"(b_)); bid = b_; \
        ws = wsp(); H = (bf16_t*)(ws + WS_H); PA = (bf16_t*)(ws + WS_PA); PB = (bf16_t*)(ws + WS_PB); YC = (bf16_t*)(ws + WS_YC); } while (0)
#define GRID_SYNC_CG() do { asm volatile("s_waitcnt vmcnt(0) lgkmcnt(0)" ::: "memory"); __builtin_amdgcn_fence(__ATOMIC_RELEASE, "agent"); grid.sync(); \
        __builtin_amdgcn_fence(__ATOMIC_ACQUIRE, "agent"); asm volatile("s_waitcnt vmcnt(0)" ::: "memory"); } while (0)
    FRESH();
    volatile LAS unsigned* bst = (volatile LAS unsigned*)(lds + LDS_BYTES - 16);
    if (tid == 0) { bst[0] = 0u; bst[1] = 0u; }
    if (bid == 0) for (int i = tid; i < XCD_BAR_WORDS; i += NTHR) ((unsigned*)ws)[i] = 0u;
    __syncthreads();
    XcdBarrier xbar; xbar.bar = (unsigned*)ws; xbar.x = 0; xbar.st = bst;
#define GRID_SYNC() REPEAT(REP_SYNC) do { xcd_barrier(xbar); } while (0)

    REPEAT(REP_PRO) phase_prologue(p, lds, tid, lane, wave, bid, G);
    DBG_CHECK(0);
    GRID_SYNC_CG(); FRESH();
    xbar = xcd_barrier_post((unsigned*)ws, bst);
    REPEAT(REP_R0) phase_rows(p, lds, tid, lane, wave, bid, G, 0, 0);
    DBG_CHECK(1);
    GRID_SYNC(); FRESH();
#pragma unroll 1
    for (int li = 0; li < 2; ++li) {
        {
            const bf16_t* W = (const bf16_t*)(ws + WS_WIN) + (size_t)li * NP * 1024;
            const int M1 = li == 0 ? MTOT : MLAT;
            pg8::Gemm g{H, W, M1, NP, 1024}; pg8::StaticOrder S; S.init(M1, NP, G, bid);
            EpiStore E{PA, NPA, PB, NPB, 6};
            GEMM_CALL(EpiStore, g, S, E);
            if (li == 1) {
                const int shift = ((MLAT / 256) * (NP / 256)) % G;
                pg8::Gemm g2{H + (size_t)MLAT * 1024, W, MCTX, 768, 1024}; pg8::StaticOrder S2; S2.init(MCTX, 768, G, (bid - shift + G) % G);
                EpiStore E2{PA + (size_t)MLAT * NPA, NPA, PB, NPB, 6};
                GEMM_CALL(EpiStore, g2, S2, E2);
            }
        }
        DBG_CHECK(2 + li * 9 + 0);
        GRID_SYNC(); FRESH();
        REPEAT(REP_X13) phase_x1(p, lds, tid, lane, wave, bid, G, li);
        DBG_CHECK(2 + li * 9 + 1);
        GRID_SYNC(); FRESH();
        {
            const int nfb = 64;
            if (bid < nfb) {
                pg8::Gemm g{(const bf16_t*)(ws + WS_DL), (const bf16_t*)(ws + WS_ZT), SEQ, NB * 256, SEQ}; pg8::StaticOrder S; S.init(SEQ, NB * 256, nfb, bid);
                EpiF2 E{YC + 512, SEQ};
                GEMM_CALL(EpiF2, g, S, E);
            } else {
                if (li == 0 && bid < nfb + 8) {
                    pg8::Gemm g{(const bf16_t*)(ws + WS_DLC), (const bf16_t*)(ws + WS_ZTC), CTXL, NB * 256, CTXL}; pg8::StaticOrder S; S.init(CTXL, NB * 256, 8, bid - nfb);
                    EpiF2 E{YC + (size_t)MLAT * D + 512, CTXL};
                    GEMM_CALL(EpiF2, g, S, E);
                }
                REPEAT(REP_X2) scan_states(p, (bid - nfb) * NTHR + tid, (G - nfb) * NTHR);
            }
        }
        DBG_CHECK(2 + li * 9 + 2);
        GRID_SYNC(); FRESH();
        REPEAT(REP_X13) if (li == 0) { for (int it = bid; it < NB * NCH * 4; it += G) { const int b = it / (NCH * 4), rem = it % (NCH * 4); g3_item(p, lds, tid, lane, wave, li, b, rem >> 2, rem & 3); } }
        else { for (int it = bid; it < NB * 32 * 4; it += G) g3_item(p, lds, tid, lane, wave, li, it >> 7, 4 + ((it >> 2) & 31), it & 3); }
        DBG_CHECK(2 + li * 9 + 3);
        GRID_SYNC(); FRESH();
        {
            const int M1 = li == 0 ? MTOT : MLAT;
            pg8::Gemm g{YC, (const bf16_t*)(ws + WS_WOUT) + (size_t)li * 1024 * 1024, M1, 1024, 1024}; pg8::StaticOrder S; S.init(M1, 1024, G, bid);
            EpiStore E{(bf16_t*)(ws + WS_Y), 1024, nullptr, 0, 1 << 20};
            GEMM_CALL(EpiStore, g, S, E);
        }
        DBG_CHECK(2 + li * 9 + 4);
        GRID_SYNC(); FRESH();
        phase_rows(p, lds, tid, lane, wave, bid, G, 1, li);
        DBG_CHECK(2 + li * 9 + 5);
        GRID_SYNC(); FRESH();
        {
            const int M1 = li == 0 ? MTOT : MLAT;
            pg8::Gemm g{H, (const bf16_t*)(ws + WS_WFI) + (size_t)li * 2 * FFH * 1024, M1, 2 * FFH, 1024}; pg8::StaticOrder S; S.init(M1, 2 * FFH, G, bid);
            EpiSwiglu E{(bf16_t*)(ws + WS_HID), FFH};
            GEMM_CALL(EpiSwiglu, g, S, E);
        }
        DBG_CHECK(2 + li * 9 + 6);
        GRID_SYNC(); FRESH();
        {
            const int M1 = li == 0 ? MTOT : MLAT;
            pg8::Gemm g{(const bf16_t*)(ws + WS_HID), (const bf16_t*)(ws + WS_WFO) + (size_t)li * 1024 * FFH, M1, 1024, FFH}; pg8::StaticOrder S; S.init(M1, 1024, G, bid);
            EpiStore E{(bf16_t*)(ws + WS_Y2), 1024, nullptr, 0, 1 << 20};
            GEMM_CALL(EpiStore, g, S, E);
        }
        DBG_CHECK(2 + li * 9 + 7);
        GRID_SYNC(); FRESH();
        phase_rows(p, lds, tid, lane, wave, bid, G, 2, li);
        DBG_CHECK(2 + li * 9 + 8);
        if (li == 0) { GRID_SYNC(); FRESH(); }
    }
}

extern "C" void kernel_launch(void* const* d_in, const int* in_sizes, int n_in, void* d_out, int out_size, void* d_ws, size_t ws_size, hipStream_t stream) {
    static int grid = 0;
    if (grid == 0) {
        if (n_in != 21 || out_size != MLAT * D || ws_size < WS_END) { fprintf(stderr, "kernel_launch: unexpected problem (n_in %d, out %d, ws %zu)\n", n_in, out_size, ws_size); grid = -1; return; }
        int dev = 0, cus = 0, per_cu = 0;
        hipGetDevice(&dev);
        hipDeviceGetAttribute(&cus, hipDeviceAttributeMultiprocessorCount, dev);
        hipFuncSetAttribute((const void*)hybrid_fwd, hipFuncAttributeMaxDynamicSharedMemorySize, LDS_BYTES);
        hipOccupancyMaxActiveBlocksPerMultiprocessor(&per_cu, (const void*)hybrid_fwd, NTHR, LDS_BYTES);
        if (per_cu < 1) per_cu = 1;
        grid = cus * 1;
        if (grid < 128) { fprintf(stderr, "kernel_launch: too few CUs (%d)\n", cus); grid = -1; return; }
    }
    if (grid < 0) return;
    Params p{};
    for (int i = 0; i < 21; ++i) p.in[i] = (const float*)d_in[i];
    p.out = (float*)d_out; p.ws = (unsigned char*)d_ws;
    void* args[] = {&p};
    hipError_t e = hipLaunchCooperativeKernel((const void*)hybrid_fwd, dim3(grid), dim3(NTHR), args, LDS_BYTES, stream);
    if (e != hipSuccess) fprintf(stderr, "cooperative launch failed: %s (grid %d)\n", hipGetErrorString(e), grid);
}
```

```cpp
#include <hip/hip_runtime.h>
#include <hip/hip_cooperative_groups.h>
#include <cstdio>
#include <cstdint>
namespace cg = cooperative_groups;
namespace pg8 {
#define PG8_LAS __attribute__((address_space(3)))
typedef unsigned short bf16_t;
typedef short bf16x8 __attribute__((ext_vector_type(8)));
typedef float f32x4 __attribute__((ext_vector_type(4)));
typedef unsigned u32x4 __attribute__((ext_vector_type(4)));
constexpr int BM = 256, BK = 64, HALF = 128, HTB = HALF * BK * 2  , STAGE_BYTES = 8 * HTB, NXCD = 8, WGM = 8;

__host__ __device__ __forceinline__ int lds_byte(int r, int c) { const int st = (r >> 4) * 2 + (c >> 5), rr = r & 15, cc = c & 31, ob = rr * 64 + cc * 2; return st * 1024 + (ob ^ (((ob >> 9) & 1) << 5)); }
__host__ __device__ __forceinline__ void stage_rc(int b, int& R, int& C) { const int st = b / 1024, sb = b % 1024, swz = sb ^ (((sb >> 9) & 1) << 5); R = (st >> 1) * 16 + swz / 64; C = (st & 1) * 32 + (swz % 64) / 2; }
__host__ __device__ __forceinline__ int perm32(int rho) { const int n = rho >> 4, i = rho & 15; return 8 * (i >> 2) + 4 * n + (i & 3); }

struct Unit { int pm, pn; };
struct Gemm { const bf16_t* A; const bf16_t* Bt; int M, N, K; };

struct StaticOrder {
    int nM, nN, nwg, G, c;
    __host__ __device__ void init(int M, int N, int G_, int c_) { nM = M / BM; nN = N / BM; nwg = nM * nN; G = G_; c = c_; }
    __host__ __device__ bool next(int i, Unit& u) const {
        const long L = (long)i * G + c; if (L >= nwg) return false;
        int wgid = (int)L; { const int q = nwg / NXCD, r = nwg % NXCD, xcd = wgid % NXCD, off = wgid / NXCD; wgid = (xcd < r ? xcd * (q + 1) : r * (q + 1) + (xcd - r) * q) + off; }
        const int nig = WGM * nN, gid = wgid / nig, fm = gid * WGM, gsz = (nM - fm) < WGM ? (nM - fm) : WGM;
        u.pm = fm + ((wgid % nig) % gsz); u.pn = (wgid % nig) / gsz; return true;
    }
    __device__ __forceinline__ void a_ready(const Unit&) const {}
    __device__ __forceinline__ void done(const Unit&) const {}
};

__device__ __forceinline__ unsigned cvt_pk_bf16(float lo, float hi) { unsigned r; asm volatile("v_cvt_pk_bf16_f32 %0, %1, %2" : "=v"(r) : "v"(lo), "v"(hi)); return r; }
template <class Epi, class Sched, bool ALIGN_EPI = false, bool SP2 = false>
__device__ __forceinline__ void gemm_phase(PG8_LAS unsigned char* lds, const Gemm g, const Sched& S, const Epi& E) {
    int tid_ = threadIdx.x; asm volatile("" : "+v"(tid_));
    const int tid = tid_, wid = __builtin_amdgcn_readfirstlane(tid >> 6), lane = tid & 63, wr = wid >> 2, wc = wid & 3, fr = lane & 15, fq = lane >> 4;
    const int K = g.K, nt = K / BK;
    unsigned voffA[2], voffB[2];
#pragma unroll
    for (int i = 0; i < 2; ++i) { int R, C; stage_rc(tid * 16 + i * 8192, R, C); const int Rb = Epi::PERM ? ((R & ~31) + perm32(R & 31)) : R;
        voffA[i] = (unsigned)(R * K + C) * 2u; voffB[i] = (unsigned)(Rb * K + C) * 2u; }
    const size_t kstep = (size_t)(BK * 2);
    const size_t hstep = (size_t)HALF * K * 2;
    const size_t tstep = 2 * hstep;
    const unsigned ldsw = (unsigned)wid * 1024u;
    const int aoff = lds_byte(wr * 64 + fr, fq * 8), boff = lds_byte(wc * 32 + fr, fq * 8);
#define PG8_SA(b, h) (((b) * 2 + (h)) * HTB)
#define PG8_SB(b, h) ((4 + (b) * 2 + (h)) * HTB)
#define PG8_STAGE(bufoff, gbase, voff) do { _Pragma("unroll") for (int _i = 0; _i < 2; ++_i) \
        __builtin_amdgcn_global_load_lds((const unsigned*)((const char*)(gbase) + (voff)[_i]), (PG8_LAS unsigned*)(lds + (bufoff) + ldsw + _i * 8192), 16, 0, 0); } while (0)
#define PG8_LDA(dst, b, h) do { _Pragma("unroll") for (int m = 0; m < 4; ++m) _Pragma("unroll") for (int k = 0; k < 2; ++k) dst[m][k] = *(const PG8_LAS bf16x8*)(lds + PG8_SA(b, h) + aoff + m * 2048 + k * 1024); } while (0)
#define PG8_LDB(dst, b, h) do { _Pragma("unroll") for (int n = 0; n < 2; ++n) _Pragma("unroll") for (int k = 0; k < 2; ++k) dst[n][k] = *(const PG8_LAS bf16x8*)(lds + PG8_SB(b, h) + boff + n * 2048 + k * 1024); } while (0)
#define PG8_MMA(ai, bj, At, Bt) do { __builtin_amdgcn_s_setprio(1); _Pragma("unroll") for (int m = 0; m < 4; ++m) _Pragma("unroll") for (int n = 0; n < 2; ++n) _Pragma("unroll") for (int k = 0; k < 2; ++k) \
        acc[ai][bj][m][n] = __builtin_amdgcn_mfma_f32_16x16x32_bf16(Bt[n][k], At[m][k], acc[ai][bj][m][n], 0, 0, 0); __builtin_amdgcn_s_setprio(0); } while (0)
#define PG8_WAIT_V(n) asm volatile("s_waitcnt vmcnt(" #n ")" ::: "memory")
#define PG8_WAIT_L(n) asm volatile("s_waitcnt lgkmcnt(" #n ")" ::: "memory")
#define PG8_BAR __builtin_amdgcn_s_barrier()
#define PG8_SCHED __builtin_amdgcn_sched_barrier(0)
    Unit cur, nxt; int ui = 0;
    if (!S.next(0, cur)) return;
    f32x4 acc[2][2][4][2];
#pragma unroll
    for (int a = 0; a < 2; ++a)
#pragma unroll
        for (int b = 0; b < 2; ++b)
#pragma unroll
            for (int m = 0; m < 4; ++m)
#pragma unroll
                for (int n = 0; n < 2; ++n) acc[a][b][m][n] = (f32x4){0.f, 0.f, 0.f, 0.f};
    bf16x8 At[4][2], B0[2][2], B1[2][2];
    const char* cA = (const char*)g.A + (size_t)cur.pm * tstep; const char* cB = (const char*)g.Bt + (size_t)cur.pn * tstep;
    S.a_ready(cur);
    if constexpr (SP2) {
        PG8_STAGE(PG8_SB(0, 0), cB, voffB); PG8_STAGE(PG8_SB(0, 1), cB + hstep, voffB); PG8_STAGE(PG8_SA(0, 0), cA, voffA); PG8_STAGE(PG8_SA(0, 1), cA + hstep, voffA);
        if (wr == 1) PG8_BAR;
        PG8_WAIT_V(2); PG8_BAR;
        PG8_STAGE(PG8_SB(1, 0), cB + kstep, voffB); PG8_STAGE(PG8_SA(1, 0), cA + kstep, voffA); PG8_STAGE(PG8_SB(1, 1), cB + hstep + kstep, voffB);
        PG8_WAIT_V(6); PG8_BAR;
    } else {
        PG8_STAGE(PG8_SB(0, 0), cB, voffB); PG8_STAGE(PG8_SA(0, 0), cA, voffA); PG8_STAGE(PG8_SB(0, 1), cB + hstep, voffB); PG8_STAGE(PG8_SA(0, 1), cA + hstep, voffA);
        if (wr == 1) PG8_BAR;
        PG8_WAIT_V(4); PG8_BAR;
        PG8_STAGE(PG8_SB(1, 0), cB + kstep, voffB); PG8_STAGE(PG8_SA(1, 0), cA + kstep, voffA); PG8_STAGE(PG8_SB(1, 1), cB + hstep + kstep, voffB);
        PG8_WAIT_V(6); PG8_BAR;
    }
    for (;;) {
        const bool has_next = S.next(ui + 1, nxt);
        const char* nA = has_next ? (const char*)g.A + (size_t)nxt.pm * tstep : cA; const char* nB = has_next ? (const char*)g.Bt + (size_t)nxt.pn * tstep : cB;
        for (int t = 0; t < nt; t += 2) {
            const bool last = (t == nt - 2);
            const char* a1 = cA + (size_t)(t + 1) * kstep;
            const char* a2 = last ? nA : cA + (size_t)(t + 2) * kstep; const char* b2 = last ? nB : cB + (size_t)(t + 2) * kstep;
            const char* a3 = a2 + kstep; const char* b3 = b2 + kstep;
            if (last && has_next) S.a_ready(nxt);
            if constexpr (SP2) {
            PG8_LDB(B0, 0, 0); PG8_LDB(B1, 0, 1); PG8_SCHED; PG8_LDA(At, 0, 0); PG8_STAGE(PG8_SA(1, 1), a1 + hstep, voffA);
            PG8_WAIT_V(8); PG8_WAIT_L(0); PG8_BAR; PG8_MMA(0, 0, At, B0); PG8_MMA(0, 1, At, B1); PG8_BAR; PG8_SCHED;
            PG8_LDA(At, 0, 1); PG8_STAGE(PG8_SB(0, 0), b2, voffB); PG8_STAGE(PG8_SB(0, 1), b2 + hstep, voffB); PG8_STAGE(PG8_SA(0, 0), a2, voffA);
            PG8_WAIT_V(8); PG8_WAIT_L(0); PG8_BAR; PG8_MMA(1, 0, At, B0); PG8_MMA(1, 1, At, B1); PG8_BAR; PG8_SCHED;
            PG8_LDB(B0, 1, 0); PG8_LDB(B1, 1, 1); PG8_SCHED; PG8_LDA(At, 1, 0); PG8_STAGE(PG8_SA(0, 1), a2 + hstep, voffA);
            PG8_WAIT_V(8); PG8_WAIT_L(0); PG8_BAR; PG8_MMA(0, 0, At, B0); PG8_MMA(0, 1, At, B1); PG8_BAR; PG8_SCHED;
            PG8_LDA(At, 1, 1); PG8_STAGE(PG8_SB(1, 0), b3, voffB); PG8_STAGE(PG8_SB(1, 1), b3 + hstep, voffB); PG8_STAGE(PG8_SA(1, 0), a3, voffA);
            PG8_WAIT_V(8); PG8_WAIT_L(0); PG8_BAR; PG8_MMA(1, 0, At, B0); PG8_MMA(1, 1, At, B1); PG8_BAR; PG8_SCHED;
            } else {
            PG8_LDB(B0, 0, 0); PG8_SCHED; PG8_LDA(At, 0, 0); PG8_STAGE(PG8_SA(1, 1), a1 + hstep, voffA);
            PG8_WAIT_L(8); PG8_BAR; PG8_WAIT_L(0); PG8_MMA(0, 0, At, B0); PG8_BAR; PG8_SCHED;
            PG8_LDB(B1, 0, 1); PG8_STAGE(PG8_SB(0, 0), b2, voffB);
            PG8_BAR; PG8_WAIT_L(0); PG8_MMA(0, 1, At, B1); PG8_BAR;
            PG8_LDA(At, 0, 1); PG8_STAGE(PG8_SA(0, 0), a2, voffA);
            PG8_BAR; PG8_WAIT_L(0); PG8_MMA(1, 0, At, B0); PG8_BAR; PG8_SCHED;
            PG8_STAGE(PG8_SB(0, 1), b2 + hstep, voffB);
            PG8_WAIT_V(6); PG8_BAR; PG8_MMA(1, 1, At, B1); PG8_BAR;
            PG8_LDB(B0, 1, 0); PG8_SCHED; PG8_LDA(At, 1, 0); PG8_STAGE(PG8_SA(0, 1), a2 + hstep, voffA);
            PG8_WAIT_L(8); PG8_BAR; PG8_WAIT_L(0); PG8_MMA(0, 0, At, B0); PG8_BAR; PG8_SCHED;
            PG8_LDB(B1, 1, 1); PG8_STAGE(PG8_SB(1, 0), b3, voffB);
            PG8_BAR; PG8_WAIT_L(0); PG8_MMA(0, 1, At, B1); PG8_BAR;
            PG8_LDA(At, 1, 1); PG8_STAGE(PG8_SA(1, 0), a3, voffA);
            PG8_BAR; PG8_WAIT_L(0); PG8_MMA(1, 0, At, B0); PG8_BAR; PG8_SCHED;
            PG8_STAGE(PG8_SB(1, 1), b3 + hstep, voffB);
            PG8_WAIT_V(6); PG8_BAR; PG8_MMA(1, 1, At, B1); PG8_BAR;
            }
        }
        if constexpr (ALIGN_EPI) { if (wr == 0) PG8_BAR; }
        if constexpr (!Epi::AFTER_DRAIN) { E(acc, cur, wr, wc, fr, fq); S.done(cur); }
        if (!has_next) break;
#pragma unroll
        for (int a = 0; a < 2; ++a)
#pragma unroll
            for (int b = 0; b < 2; ++b)
#pragma unroll
                for (int m = 0; m < 4; ++m)
#pragma unroll
                    for (int n = 0; n < 2; ++n) acc[a][b][m][n] = (f32x4){0.f, 0.f, 0.f, 0.f};
        cur = nxt; cA = nA; cB = nB; ++ui;
        if constexpr (ALIGN_EPI) { if (wr == 1) PG8_BAR; }
    }
    PG8_WAIT_V(0);
    if constexpr (!ALIGN_EPI) { if (wr == 0) PG8_BAR; }
    PG8_BAR;
    if constexpr (Epi::AFTER_DRAIN) { E.fused(acc, cur, wr, wc, fr, fq, lds, wid, lane); S.done(cur); }
#undef PG8_SA
#undef PG8_SB
#undef PG8_STAGE
#undef PG8_LDA
#undef PG8_LDB
#undef PG8_MMA
#undef PG8_WAIT_V
#undef PG8_WAIT_L
#undef PG8_BAR
#undef PG8_SCHED
}
}

#define LAS __attribute__((address_space(3)))
typedef unsigned short bf16_t;
typedef short bf16x8 __attribute__((ext_vector_type(8)));
typedef float f32x4 __attribute__((ext_vector_type(4)));
typedef float f32x2 __attribute__((ext_vector_type(2)));
typedef unsigned u32x4 __attribute__((ext_vector_type(4)));
typedef unsigned u32x2 __attribute__((ext_vector_type(2)));

constexpr int D = 1024, NB = 8, SEQ = 2048, CTXL = 256, MLAT = NB * SEQ, MCTX = NB * CTXL, MTOT = MLAT + MCTX;
constexpr int INC = 2592, NP = 2560, NPA = 1536, NPB = 1024, FFH = 2816;
constexpr int NCH = 36;
constexpr int NTHR = 512;
constexpr float EPS = 1e-6f;
constexpr int LDS_BYTES = 147456;

constexpr size_t MiB = 1u << 20;
constexpr size_t WS_WIN = 1 * MiB;
constexpr size_t WS_WOUT = 11 * MiB;
constexpr size_t WS_WFI = 15 * MiB;
constexpr size_t WS_WFO = 37 * MiB;
constexpr size_t WS_MOD = 48 * MiB;
constexpr size_t WS_PE = WS_MOD + 512 * 1024;
constexpr size_t WS_WLR = WS_PE + 128 * 1024;
constexpr size_t WS_DEC = WS_WLR + 256 * 1024;
constexpr size_t WS_DL = 50 * MiB;
constexpr size_t WS_DLC = 58 * MiB;
constexpr size_t WS_XC = 59 * MiB;
constexpr size_t WS_LR = 67 * MiB;
constexpr size_t WS_H = 70 * MiB;
constexpr size_t WS_PA = 106 * MiB;
constexpr size_t WS_PB = 160 * MiB;
constexpr size_t WS_YC = 196 * MiB;
constexpr size_t WS_ZT = 232 * MiB;
constexpr size_t WS_ZTC = 240 * MiB;
constexpr size_t WS_HID = 106 * MiB;
constexpr size_t WS_Y = 106 * MiB;
constexpr size_t WS_Y2 = 205 * MiB;
constexpr size_t WS_END = 241 * MiB;

struct Params { const float* in[21]; float* out; unsigned char* ws; };
typedef __attribute__((address_space(4))) const unsigned char kchar;
__device__ __forceinline__ kchar* kargs() { kchar* ka = (kchar*)__builtin_amdgcn_kernarg_segment_ptr(); asm volatile("" : "+s"(ka)); return ka; }
__device__ __forceinline__ const float* inp(int i) { return *(const float* __attribute__((address_space(4))) const*)(kargs() + 8 * i); }
__device__ __forceinline__ float* outp() { return *(float* __attribute__((address_space(4))) const*)(kargs() + 8 * 21); }
__device__ __forceinline__ unsigned char* wsp() { return *(unsigned char* __attribute__((address_space(4))) const*)(kargs() + 8 * 22); }

__device__ __forceinline__ float bf2f(unsigned short b) { return __uint_as_float(((unsigned)b) << 16); }
typedef __bf16 bf16x2_t __attribute__((ext_vector_type(2)));
__device__ __forceinline__ unsigned pkbf(float lo, float hi) { f32x2 v; v[0] = lo; v[1] = hi; const bf16x2_t b = __builtin_convertvector(v, bf16x2_t); return __builtin_bit_cast(unsigned, b); }
__device__ __forceinline__ unsigned short f2bf(float f) { return (unsigned short)(pkbf(f, 0.f) & 0xffffu); }
__device__ __forceinline__ float lo16(unsigned r) { return __uint_as_float(r << 16); }
__device__ __forceinline__ float hi16(unsigned r) { return __uint_as_float(r & 0xffff0000u); }
__device__ __forceinline__ float wave_sum(float v) {
#pragma unroll
    for (int o = 1; o < 64; o <<= 1) v += __shfl_xor(v, o);
    return v;
}
__device__ __forceinline__ float silu_f(float a) { return a / (1.f + __expf(-a)); }
__device__ __forceinline__ float logsig16(float z) { return (fminf(z, 0.f) - __logf(1.f + __expf(-fabsf(z)))) * (1.f / 16.f); }

struct EpiStore {
    static constexpr bool PERM = true, AFTER_DRAIN = false;
    bf16_t* O0; int ld0; bf16_t* O1; int ld1; int split;
    __device__ __forceinline__ void operator()(const pg8::f32x4 (&acc)[2][2][4][2], const pg8::Unit& u, int wr, int wc, int fr, int fq) const {
        const int row0 = u.pm * 256 + wr * 64 + fr;
        bf16_t* base; int ld, colt;
        if (u.pn < split) { base = O0; ld = ld0; colt = u.pn * 256; } else { base = O1; ld = ld1; colt = (u.pn - split) * 256; }
        const int col0 = colt + wc * 32 + 8 * fq;
#pragma unroll
        for (int ai = 0; ai < 2; ++ai)
#pragma unroll
            for (int m = 0; m < 4; ++m) { bf16_t* rowp = base + (size_t)(row0 + ai * 128 + m * 16) * ld + col0;
#pragma unroll
                for (int bj = 0; bj < 2; ++bj) { const pg8::f32x4 v0 = acc[ai][bj][m][0], v1 = acc[ai][bj][m][1];
                    u32x4 w; w.x = pkbf(v0[0], v0[1]); w.y = pkbf(v0[2], v0[3]); w.z = pkbf(v1[0], v1[1]); w.w = pkbf(v1[2], v1[3]);
                    *(u32x4*)(rowp + bj * 128) = w; } }
    }
};
struct EpiF2 {
    static constexpr bool PERM = true, AFTER_DRAIN = false;
    bf16_t* O; int L;
    __device__ __forceinline__ void operator()(const pg8::f32x4 (&acc)[2][2][4][2], const pg8::Unit& u, int wr, int wc, int fr, int fq) const {
        const int row0 = u.pn * L + u.pm * 256 + wr * 64 + fr;
        const int col0 = wc * 32 + 8 * fq;
#pragma unroll
        for (int ai = 0; ai < 2; ++ai)
#pragma unroll
            for (int m = 0; m < 4; ++m) { bf16_t* rowp = O + (size_t)(row0 + ai * 128 + m * 16) * D + col0;
#pragma unroll
                for (int bj = 0; bj < 2; ++bj) { const pg8::f32x4 v0 = acc[ai][bj][m][0], v1 = acc[ai][bj][m][1];
                    u32x4 w; w.x = pkbf(v0[0], v0[1]); w.y = pkbf(v0[2], v0[3]); w.z = pkbf(v1[0], v1[1]); w.w = pkbf(v1[2], v1[3]);
                    *(u32x4*)(rowp + bj * 128) = w; } }
    }
};
struct EpiSwiglu {
    static constexpr bool PERM = true, AFTER_DRAIN = false;
    bf16_t* O; int ld;
    __device__ __forceinline__ void operator()(const pg8::f32x4 (&acc)[2][2][4][2], const pg8::Unit& u, int wr, int wc, int fr, int fq) const {
        const int row0 = u.pm * 256 + wr * 64 + fr;
        const int col0 = u.pn * 128 + wc * 32 + 8 * fq;
#pragma unroll
        for (int ai = 0; ai < 2; ++ai)
#pragma unroll
            for (int m = 0; m < 4; ++m) { bf16_t* rowp = O + (size_t)(row0 + ai * 128 + m * 16) * ld + col0;
                const pg8::f32x4 a0 = acc[ai][0][m][0], a1 = acc[ai][0][m][1], u0 = acc[ai][1][m][0], u1 = acc[ai][1][m][1];
                u32x4 w;
                w.x = pkbf(silu_f(a0[0]) * u0[0], silu_f(a0[1]) * u0[1]); w.y = pkbf(silu_f(a0[2]) * u0[2], silu_f(a0[3]) * u0[3]);
                w.z = pkbf(silu_f(a1[0]) * u1[0], silu_f(a1[1]) * u1[1]); w.w = pkbf(silu_f(a1[2]) * u1[2], silu_f(a1[3]) * u1[3]);
                *(u32x4*)rowp = w; }
    }
};

__device__ __forceinline__ void transpose_item(const float* W, int K, int N, int k0, int n0, bf16_t* WT, int dst_row0, LAS float* scr, int lane) {
#pragma unroll 8
    for (int i = 0; i < 32; ++i) { const int kk = 2 * i + (lane >> 5); scr[kk * 33 + (lane & 31)] = W[(size_t)(k0 + kk) * N + n0 + (lane & 31)]; }
    asm volatile("s_waitcnt lgkmcnt(0)" ::: "memory");
    const int c = lane & 7;
#pragma unroll
    for (int j = 0; j < 4; ++j) { const int n = (lane >> 3) + 8 * j; const LAS float* s = scr + (8 * c) * 33 + n;
        u32x4 o; o.x = pkbf(s[0 * 33], s[1 * 33]); o.y = pkbf(s[2 * 33], s[3 * 33]); o.z = pkbf(s[4 * 33], s[5 * 33]); o.w = pkbf(s[6 * 33], s[7 * 33]);
        *(u32x4*)(WT + (size_t)(dst_row0 + n) * K + k0 + 8 * c) = o; }
    asm volatile("s_waitcnt lgkmcnt(0)" ::: "memory");
}

__device__ __forceinline__ void phase_prologue(const Params& p, LAS unsigned char* lds, int tid, int lane, int wave, int bid, int G) {
    unsigned char* ws = wsp();
    __syncthreads();
    {
        LAS float* sc = (LAS float*)lds;
        LAS float* red = (LAS float*)(lds + 36864);
        float* MOD = (float*)(ws + WS_MOD);
        for (int it = bid; it < 48; it += G) {
            const int li = it / 24, jb = it % 24;
            for (int e = tid; e < 9 * 1024; e += NTHR) { const int r = e >> 10, k = e & 1023; const float cv = r < 8 ? inp(1)[r * 1024 + k] : inp(3)[k]; sc[e] = cv / (1.f + expf(-cv)); }
            __syncthreads();
            float acc[9][4];
#pragma unroll
            for (int r = 0; r < 9; ++r) { acc[r][0] = 0.f; acc[r][1] = 0.f; acc[r][2] = 0.f; acc[r][3] = 0.f; }
            const float* wm = inp(4) + ((size_t)li * 1024 + wave * 128) * 6144 + jb * 256 + lane * 4;
#pragma unroll 4
            for (int k = 0; k < 128; ++k) { const f32x4 wv = *(const f32x4*)(wm + (size_t)k * 6144);
#pragma unroll
                for (int r = 0; r < 9; ++r) { const float s = sc[r * 1024 + wave * 128 + k]; acc[r][0] += s * wv[0]; acc[r][1] += s * wv[1]; acc[r][2] += s * wv[2]; acc[r][3] += s * wv[3]; } }
#pragma unroll
            for (int r = 0; r < 9; ++r) { f32x4 o; o[0] = acc[r][0]; o[1] = acc[r][1]; o[2] = acc[r][2]; o[3] = acc[r][3]; *(LAS f32x4*)(red + ((wave * 9 + r) * 256 + lane * 4)) = o; }
            __syncthreads();
            for (int e = tid; e < 9 * 256; e += NTHR) { const int r = e >> 8, jj = e & 255; float s = inp(5)[li * 6144 + jb * 256 + jj];
#pragma unroll
                for (int w = 0; w < 8; ++w) s += red[(w * 9 + r) * 256 + jj];
                MOD[(size_t)(li * 9 + r) * 6144 + jb * 256 + jj] = s; }
            __syncthreads();
        }
    }
    {
        LAS float* scr = (LAS float*)(lds + wave * 16384);
        const int gw = bid * 8 + wave, NGW = G * 8;
        constexpr int I_IN = 16 * 81, I_OUT = 16 * 32, I_FI = 16 * 176, I_FO = 44 * 32, I_L = I_IN + I_OUT + I_FI + I_FO;
        bf16_t* Win_t = (bf16_t*)(ws + WS_WIN); bf16_t* Wout_t = (bf16_t*)(ws + WS_WOUT); bf16_t* Wfi_t = (bf16_t*)(ws + WS_WFI); bf16_t* Wfo_t = (bf16_t*)(ws + WS_WFO);
        float* WLR = (float*)(ws + WS_WLR);
        for (int it = gw; it < 2 * I_L; it += NGW) {
            const int li = it / I_L; int r = it % I_L;
            if (r < I_IN) { const int kb = r / 81, nb = r % 81, n0 = nb * 32, k0 = kb * 64; const float* W = inp(10) + (size_t)li * 1024 * INC;
                if (n0 == 768) {
#pragma unroll 8
                    for (int i = 0; i < 32; ++i) { const int kk = 2 * i + (lane >> 5); WLR[(size_t)(li * 1024 + k0 + kk) * 32 + (lane & 31)] = W[(size_t)(k0 + kk) * INC + 768 + (lane & 31)]; }
                } else transpose_item(W, 1024, INC, k0, n0, Win_t + (size_t)li * NP * 1024, n0 < 768 ? n0 : n0 - 32, scr, lane);
                continue; }
            r -= I_IN;
            if (r < I_OUT) { const int kb = r / 32, nb = r % 32; transpose_item(inp(18) + (size_t)li * 1024 * 1024, 1024, 1024, kb * 64, nb * 32, Wout_t + (size_t)li * 1024 * 1024, nb * 32, scr, lane); continue; }
            r -= I_OUT;
            if (r < I_FI) { const int kb = r / 176, nb = r % 176, n0 = nb * 32; const int j0 = n0 < FFH ? n0 : n0 - FFH; const int dst = 256 * (j0 / 128) + (j0 % 128) + (n0 < FFH ? 0 : 128);
                transpose_item(inp(19) + (size_t)li * 1024 * 2 * FFH, 1024, 2 * FFH, kb * 64, n0, Wfi_t + (size_t)li * 2 * FFH * 1024, dst, scr, lane); continue; }
            r -= I_FI;
            { const int kb = r / 32, nb = r % 32; transpose_item(inp(20) + (size_t)li * FFH * 1024, FFH, 1024, kb * 64, nb * 32, Wfo_t + (size_t)li * 1024 * FFH, nb * 32, scr, lane); }
        }
    }
    {
        const int gt = bid * NTHR + tid, NT = G * NTHR;
        float* PE = (float*)(ws + WS_PE);
        for (int e = gt; e < 64 * 512; e += NT) { const int pp = e >> 9, dd = e & 511, i = dd & 255; const float f = 1.0f / powf(10000.0f, (float)i / 256.0f); const float ang = (float)pp * f; PE[e] = dd < 256 ? sinf(ang) : cosf(ang); }
        bf16_t* DL = (bf16_t*)(ws + WS_DL);
        const float sL = 0.022097086912079608f;
        for (int it = gt; it < 2048 * 256; it += NT) { const int lp = it >> 8, k8 = (it & 255) * 8; float v[8];
#pragma unroll
            for (int j = 0; j < 8; ++j) { const int k = k8 + j; v[j] = (k <= 1024) ? cospif((float)((lp * k) & 2047) * (1.0f / 1024.0f)) * sL : -sinpif((float)((lp * (k - 1024)) & 2047) * (1.0f / 1024.0f)) * sL; }
            u32x4 o; o.x = pkbf(v[0], v[1]); o.y = pkbf(v[2], v[3]); o.z = pkbf(v[4], v[5]); o.w = pkbf(v[6], v[7]); *(u32x4*)(DL + (size_t)lp * 2048 + k8) = o; }
        bf16_t* DLC = (bf16_t*)(ws + WS_DLC);
        for (int it = gt; it < 256 * 32; it += NT) { const int lp = it >> 5, k8 = (it & 31) * 8; float v[8];
#pragma unroll
            for (int j = 0; j < 8; ++j) { const int k = k8 + j; v[j] = (k <= 128) ? cospif((float)((lp * k) & 255) * (1.0f / 128.0f)) * 0.0625f : -sinpif((float)((lp * (k - 128)) & 255) * (1.0f / 128.0f)) * 0.0625f; }
            u32x4 o; o.x = pkbf(v[0], v[1]); o.y = pkbf(v[2], v[3]); o.z = pkbf(v[4], v[5]); o.w = pkbf(v[6], v[7]); *(u32x4*)(DLC + (size_t)lp * 256 + k8) = o; }
    }
}

__device__ __forceinline__ void phase_rows(const Params& p, LAS unsigned char* lds, int tid, int lane, int wave, int bid, int G, int kind, int li) {
    unsigned char* ws = wsp();
    const bool need_h = !(kind == 2 && li == 1);
    const bool need_lr = need_h && kind != 1;
    const int lh = (kind == 1) ? li : (kind == 0 ? 0 : li + 1);
    const int nrows = (li == 1 && kind >= 1) ? MLAT : MTOT;
    LAS float* wl = (LAS float*)lds;
    const float* MOD = (const float*)(ws + WS_MOD);
    const float* PE = (const float*)(ws + WS_PE);
    float* XC = (float*)(ws + WS_XC);
    bf16_t* H = (bf16_t*)(ws + WS_H);
    float* LR = (float*)(ws + WS_LR);
    const bf16_t* Yb = (const bf16_t*)(ws + (kind == 1 ? WS_Y : WS_Y2));
    __syncthreads();
    if (need_lr) {
        const float* WLR = (const float*)(ws + WS_WLR) + (size_t)lh * 1024 * 32;
        for (int e = tid; e < 32768; e += NTHR) { const int k = e >> 5, c = e & 31; wl[(k >> 2) * 132 + 4 * c + (k & 3)] = WLR[e]; }
        __syncthreads();
    }
    const int nw = G * 8, rpw = (nrows + nw - 1) / nw;
    const int r0 = (bid * 8 + wave) * rpw, r1 = (r0 + rpw < nrows) ? r0 + rpw : nrows;
    if (r0 >= r1) return;
    f32x4 cA[4], cB[4], cC[4]; int cur_b = -1;
    f32x4 xv[4]; u32x2 yv2[4];
#define ROW_LOAD(r_, X_, Y_) do { const int rr_ = (r_); const bool lat_ = rr_ < MLAT; \
        const float* xin_ = (kind == 0) ? (lat_ ? inp(0) + (size_t)rr_ * D : inp(2) + (size_t)(rr_ - MLAT) * D) : (lat_ ? outp() + (size_t)rr_ * D : XC + (size_t)(rr_ - MLAT) * D); \
        _Pragma("unroll") for (int j = 0; j < 4; ++j) X_[j] = *(const f32x4*)(xin_ + 4 * lane + 256 * j); \
        if (kind == 0 && lat_) { const int t_ = rr_ & 2047; const float* pa_ = PE + (t_ >> 6) * 512; const float* pb_ = PE + (t_ & 63) * 512; \
            X_[0] += *(const f32x4*)(pa_ + 4 * lane); X_[1] += *(const f32x4*)(pa_ + 4 * lane + 256); X_[2] += *(const f32x4*)(pb_ + 4 * lane); X_[3] += *(const f32x4*)(pb_ + 4 * lane + 256); } \
        if (kind >= 1) { _Pragma("unroll") for (int j = 0; j < 4; ++j) Y_[j] = *(const u32x2*)(Yb + (size_t)rr_ * D + 4 * lane + 256 * j); } } while (0)
    ROW_LOAD(r0, xv, yv2);
#pragma unroll 1
    for (int r = r0; r < r1; ++r) {
        f32x4 xn[4]; u32x2 yn2[4];
        if (r + 1 < r1) ROW_LOAD(r + 1, xn, yn2);
        const bool lat = r < MLAT;
        const int bidx = lat ? (r >> 11) : 8;
        if (bidx != cur_b) {
            cur_b = bidx;
            if (kind >= 1) { const float* gate = MOD + (size_t)(li * 9 + bidx) * 6144 + (kind == 1 ? 2 : 5) * 1024; const float* gp = inp(kind == 1 ? 7 : 9) + li * 1024;
#pragma unroll
                for (int j = 0; j < 4; ++j) cA[j] = *(const f32x4*)(gate + 4 * lane + 256 * j) * *(const f32x4*)(gp + 4 * lane + 256 * j); }
            if (need_h) { const float* gpre = inp(kind == 1 ? 8 : 6) + lh * 1024; const float* md = MOD + (size_t)(lh * 9 + bidx) * 6144 + (kind == 1 ? 3 * 1024 : 0);
#pragma unroll
                for (int j = 0; j < 4; ++j) { cB[j] = *(const f32x4*)(gpre + 4 * lane + 256 * j) * (*(const f32x4*)(md + 1024 + 4 * lane + 256 * j) + 1.0f); cC[j] = *(const f32x4*)(md + 4 * lane + 256 * j); } }
        }
        float* xout = lat ? outp() + (size_t)r * D : XC + (size_t)(r - MLAT) * D;
        if (kind >= 1) {
            f32x4 yf[4]; float ss = 0.f;
#pragma unroll
            for (int j = 0; j < 4; ++j) { yf[j][0] = lo16(yv2[j][0]); yf[j][1] = hi16(yv2[j][0]); yf[j][2] = lo16(yv2[j][1]); yf[j][3] = hi16(yv2[j][1]);
                ss += (yf[j][0] * yf[j][0] + yf[j][1] * yf[j][1]) + (yf[j][2] * yf[j][2] + yf[j][3] * yf[j][3]); }
            ss = wave_sum(ss); const float rs = rsqrtf(ss * (1.0f / 1024.0f) + EPS);
#pragma unroll
            for (int j = 0; j < 4; ++j) xv[j] += cA[j] * (yf[j] * rs);
        }
#pragma unroll
        for (int j = 0; j < 4; ++j) *(f32x4*)(xout + 4 * lane + 256 * j) = xv[j];
        if (need_h) {
            float ss2 = 0.f;
#pragma unroll
            for (int j = 0; j < 4; ++j) ss2 += (xv[j][0] * xv[j][0] + xv[j][1] * xv[j][1]) + (xv[j][2] * xv[j][2] + xv[j][3] * xv[j][3]);
            ss2 = wave_sum(ss2); const float rs2 = rsqrtf(ss2 * (1.0f / 1024.0f) + EPS);
            f32x4 hv[4];
#pragma unroll
            for (int j = 0; j < 4; ++j) { hv[j] = (xv[j] * rs2) * cB[j] + cC[j]; u32x2 o; o[0] = pkbf(hv[j][0], hv[j][1]); o[1] = pkbf(hv[j][2], hv[j][3]); *(u32x2*)(H + (size_t)r * D + 4 * lane + 256 * j) = o; }
            if (need_lr) {
                float acc[32];
#pragma unroll
                for (int c = 0; c < 32; ++c) acc[c] = 0.f;
#pragma unroll
                for (int j = 0; j < 4; ++j) {
                    const LAS f32x4* wp;
                    { LAS float* bp = wl + (lane + 128 * (j >> 1)) * 132; asm volatile("" : "+v"(bp)); wp = (const LAS f32x4*)(bp + 64 * 132 * (j & 1)); }
#pragma unroll
                    for (int c = 0; c < 32; ++c) { const f32x4 w4 = wp[c]; acc[c] += (hv[j][0] * w4[0] + hv[j][1] * w4[1]) + (hv[j][2] * w4[2] + hv[j][3] * w4[3]);
                        if ((c & 7) == 7) __builtin_amdgcn_sched_barrier(0); } }
                float a16[16], a8[8], a4[4], a2[2];
                { const bool up = (lane & 32) != 0;
#pragma unroll
                  for (int c = 0; c < 16; ++c) { const float keep = up ? acc[c + 16] : acc[c], send = up ? acc[c] : acc[c + 16]; a16[c] = keep + __shfl_xor(send, 32); } }
                { const bool up = (lane & 16) != 0;
#pragma unroll
                  for (int c = 0; c < 8; ++c) { const float keep = up ? a16[c + 8] : a16[c], send = up ? a16[c] : a16[c + 8]; a8[c] = keep + __shfl_xor(send, 16); } }
                { const bool up = (lane & 8) != 0;
#pragma unroll
                  for (int c = 0; c < 4; ++c) { const float keep = up ? a8[c + 4] : a8[c], send = up ? a8[c] : a8[c + 4]; a4[c] = keep + __shfl_xor(send, 8); } }
                { const bool up = (lane & 4) != 0;
#pragma unroll
                  for (int c = 0; c < 2; ++c) { const float keep = up ? a4[c + 2] : a4[c], send = up ? a4[c] : a4[c + 2]; a2[c] = keep + __shfl_xor(send, 4); } }
                float a1;
                { const bool up = (lane & 2) != 0; const float keep = up ? a2[1] : a2[0], send = up ? a2[0] : a2[1]; a1 = keep + __shfl_xor(send, 2); }
                a1 += __shfl_xor(a1, 1);
                if ((lane & 1) == 0) LR[(size_t)r * 32 + (lane >> 1)] = a1;
            }
        }
#pragma unroll
        for (int j = 0; j < 4; ++j) { xv[j] = xn[j]; yv2[j] = yn2[j]; }
    }
#undef ROW_LOAD
}

__device__ __forceinline__ void f1_item(const Params& p, LAS unsigned char* lds, int tid, int lane, int wave, int it) {
    unsigned char* ws = wsp();
    const bf16_t* PB = (const bf16_t*)(ws + WS_PB);
    int b, tb, L, seqbase; bf16_t* ZT;
    if (it < 128) { b = it >> 4; tb = it & 15; L = SEQ; seqbase = b * SEQ; ZT = (bf16_t*)(ws + WS_ZT); }
    else { const int ic = it - 128; b = ic >> 1; tb = ic & 1; L = CTXL; seqbase = MLAT + b * CTXL; ZT = (bf16_t*)(ws + WS_ZTC); }
    const int Lh = L >> 1;
    LAS bf16_t* ue_s = (LAS bf16_t*)(lds);
    LAS bf16_t* uo_s = (LAS bf16_t*)(lds + 33792);
    LAS bf16_t* cc_s = (LAS bf16_t*)(lds + 67584);
    LAS bf16_t* sc_s = (LAS bf16_t*)(lds + 76800);
    LAS float* sp_s = (LAS float*)(lds + 86016);
#pragma unroll
    for (int q = 0; q < 4; ++q) {
        const int e = tid + NTHR * q, t = e >> 5, c8 = e & 31, l = 64 * tb + t;
        const u32x4 a = *(const u32x4*)(PB + (size_t)(seqbase + l) * NPB + c8 * 8);
        u32x4 m = (u32x4){0u, 0u, 0u, 0u};
        if (l > 0) m = *(const u32x4*)(PB + (size_t)(seqbase + L - l) * NPB + c8 * 8);
        u32x4 se, so;
#pragma unroll
        for (int w = 0; w < 4; ++w) { const float a0 = lo16(a[w]), a1 = hi16(a[w]), m0 = lo16(m[w]), m1 = hi16(m[w]);
            se[w] = pkbf(a0 + m0, a1 + m1); so[w] = (l > 0) ? pkbf(a0 - m0, a1 - m1) : 0u; }
        *(LAS u32x4*)(ue_s + t * 264 + c8 * 8) = se; *(LAS u32x4*)(uo_s + t * 264 + c8 * 8) = so;
    }
    if (tb == 0 && tid < 256) sp_s[tid] = bf2f(PB[(size_t)(seqbase + Lh) * NPB + tid]);
    __syncthreads();
    const int fr = lane & 15, fq = lane >> 4;
    const int g = wave >> 1, typ = wave & 1;
    const LAS bf16_t* src = typ ? uo_s : ue_s; const LAS bf16_t* mat = typ ? sc_s : cc_s;
#pragma unroll
    for (int lt = 0; lt < 4; ++lt) {
        bf16x8 a0 = *(const LAS bf16x8*)(src + (16 * lt + fr) * 264 + 64 * g + 8 * fq), a1 = *(const LAS bf16x8*)(src + (16 * lt + fr) * 264 + 64 * g + 32 + 8 * fq);
#pragma unroll
        for (int ct = 0; ct < 4; ++ct) {
            const bf16x8 b0 = *(const LAS bf16x8*)(mat + (16 * ct + fr) * 72 + 8 * fq), b1 = *(const LAS bf16x8*)(mat + (16 * ct + fr) * 72 + 32 + 8 * fq);
            f32x4 acc = (f32x4){0.f, 0.f, 0.f, 0.f};
            acc = __builtin_amdgcn_mfma_f32_16x16x32_bf16(a0, b0, acc, 0, 0, 0);
            acc = __builtin_amdgcn_mfma_f32_16x16x32_bf16(a1, b1, acc, 0, 0, 0);
            if (typ == 1 && tb == 0 && lt == 0 && fq == 0) {
                float s = 0.f;
                for (int c = 0; c < 64; ++c) s += sp_s[64 * g + c] * bf2f(cc_s[(16 * ct + fr) * 72 + c]);
                acc[0] = s;
            }
            const int n = b * 256 + g * 64 + 16 * ct + fr, kidx = typ * Lh + 64 * tb + 16 * lt + 4 * fq;
            u32x2 o; o[0] = pkbf(acc[0], acc[1]); o[1] = pkbf(acc[2], acc[3]);
            *(u32x2*)(ZT + (size_t)n * L + kidx) = o;
        }
    }
    __syncthreads();
}

__device__ __forceinline__ float logsig_z(const LAS float* lrow, const float (&wd)[16], float bd) {
    const LAS f32x4* lp = (const LAS f32x4*)lrow; float z = bd;
#pragma unroll
    for (int q = 0; q < 4; ++q) { const f32x4 l4 = lp[q]; z += l4[0] * wd[4 * q] + l4[1] * wd[4 * q + 1] + l4[2] * wd[4 * q + 2] + l4[3] * wd[4 * q + 3]; }
    return logsig16(z);
}

__device__ __forceinline__ void g1_item(const Params& p, LAS unsigned char* lds, int tid, int lane, int wave, int li, int it) {
    unsigned char* ws = wsp();
    const int dir = it & 1, h = (it >> 1) & 3, bc = it >> 3, cidx = bc % NCH, b = bc / NCH;
    const int row0 = cidx < 4 ? MLAT + b * CTXL + cidx * 64 : b * SEQ + (cidx - 4) * 64;
    const int unit = (b * 4 + h) * 2 + dir;
    LAS float* lr_s = (LAS float*)(lds);
    LAS float* wd_s = (LAS float*)(lds + 4096);
    LAS float* seg_s = (LAS float*)(lds + 8192);
    LAS bf16_t* ku_s = (LAS bf16_t*)(lds + 10240);
    LAS bf16_t* v_s = (LAS bf16_t*)(lds + 19456);
    const bf16_t* PA = (const bf16_t*)(ws + WS_PA);
    const float* LR = (const float*)(ws + WS_LR);
    const float* wdec = inp(dir ? 13 : 11) + li * 16 * 256; const float* bdec = inp(dir ? 14 : 12) + li * 256;
    const int d = tid & 63, tg = wave;
#pragma unroll
    for (int q = 0; q < 2; ++q) { const int e = tid + NTHR * q; const int t = e >> 4, rr = e & 15; lr_s[e] = LR[(size_t)(row0 + t) * 32 + dir * 16 + rr];
        wd_s[e] = wdec[(e >> 6) * 256 + h * 64 + (e & 63)];
        *(LAS u32x4*)(v_s + t * 136 + rr * 8) = *(const u32x4*)(PA + (size_t)(row0 + t) * NPA + 256 + h * 128 + rr * 8); }
    float kk[8];
#pragma unroll
    for (int i = 0; i < 8; ++i) kk[i] = bf2f(PA[(size_t)(row0 + 8 * tg + i) * NPA + h * 64 + d]);
    const float bd = bdec[h * 64 + d];
    __syncthreads();
    float wd[16];
#pragma unroll
    for (int r = 0; r < 16; ++r) wd[r] = wd_s[r * 64 + d];
    float c[8];
#pragma unroll
    for (int i = 0; i < 8; ++i) c[i] = logsig_z(lr_s + (8 * tg + i) * 16, wd, bd);
    if (dir == 0) {
#pragma unroll
        for (int i = 1; i < 8; ++i) c[i] += c[i - 1];
    } else {
#pragma unroll
        for (int i = 6; i >= 0; --i) c[i] += c[i + 1];
    }
    seg_s[tg * 64 + d] = dir == 0 ? c[7] : c[0];
    __syncthreads();
    float off = 0.f, tot = 0.f;
#pragma unroll
    for (int g = 0; g < 8; ++g) { const float s = seg_s[g * 64 + d]; tot += s; if (dir == 0 ? (g < tg) : (g > tg)) off += s; }
    const float base = tot - off;
    u32x4 pk;
    pk[0] = pkbf(kk[0] * __expf(base - c[0]), kk[1] * __expf(base - c[1])); pk[1] = pkbf(kk[2] * __expf(base - c[2]), kk[3] * __expf(base - c[3]));
    pk[2] = pkbf(kk[4] * __expf(base - c[4]), kk[5] * __expf(base - c[5])); pk[3] = pkbf(kk[6] * __expf(base - c[6]), kk[7] * __expf(base - c[7]));
    *(LAS u32x4*)(ku_s + d * 72 + 8 * tg) = pk;
    if (tg == 0) ((float*)(ws + WS_DEC))[(size_t)(unit * NCH + cidx) * 64 + d] = __expf(tot);
    __syncthreads();
    const int fr = lane & 15, fq = lane >> 4;
    bf16x8 vb[2];
#pragma unroll
    for (int ks = 0; ks < 2; ++ks)
#pragma unroll
        for (int j = 0; j < 8; ++j) vb[ks][j] = (short)v_s[(32 * ks + 8 * fq + j) * 136 + 16 * wave + fr];
    bf16_t* dso = (bf16_t*)(ws + WS_H) + ((size_t)(unit * NCH + cidx) * 128 + 16 * wave + fr) * 64 + 4 * fq;
#pragma unroll
    for (int dt = 0; dt < 4; ++dt) {
        f32x4 acc = (f32x4){0.f, 0.f, 0.f, 0.f};
#pragma unroll
        for (int ks = 0; ks < 2; ++ks) { const bf16x8 a = *(const LAS bf16x8*)(ku_s + (16 * dt + fr) * 72 + 32 * ks + 8 * fq); acc = __builtin_amdgcn_mfma_f32_16x16x32_bf16(a, vb[ks], acc, 0, 0, 0); }
        u32x2 o; o[0] = pkbf(acc[0], acc[1]); o[1] = pkbf(acc[2], acc[3]);
        *(u32x2*)(dso + 16 * dt) = o;
    }
    __syncthreads();
}

__device__ __forceinline__ void phase_x1(const Params& p, LAS unsigned char* lds, int tid, int lane, int wave, int bid, int G, int li) {
    unsigned char* ws = wsp();
#ifndef DBG_X1
#define DBG_X1 7
#endif
    if (DBG_X1 & 1) {
        LAS bf16_t* cc_s = (LAS bf16_t*)(lds + 67584); LAS bf16_t* sc_s = (LAS bf16_t*)(lds + 76800);
        for (int e = tid; e < 4096; e += NTHR) { const int cp = e >> 6, c = e & 63; const float x = (float)((cp * c) & 63) * (1.0f / 32.0f); cc_s[cp * 72 + c] = f2bf(cospif(x) * 0.125f); sc_s[cp * 72 + c] = f2bf(sinpif(x) * 0.125f); }
        __syncthreads();
        const int nF1 = li == 0 ? 144 : 128;
        for (int it = bid; it < nF1; it += G) f1_item(p, lds, tid, lane, wave, it);
    }
    if (DBG_X1 & 2) {
        const bf16_t* PB = (const bf16_t*)(ws + WS_PB); bf16_t* YC = (bf16_t*)(ws + WS_YC);
        const float* cw = inp(16) + li * 3 * 256; const float* cb = inp(17) + li * 256;
        const int nrows = li == 0 ? MTOT : MLAT;
        for (int it = bid * NTHR + tid; it < nrows * 32; it += G * NTHR) {
            const int r = it >> 5, c8 = it & 31;
            const int t = r < MLAT ? (r & 2047) : ((r - MLAT) & 255); const int L = r < MLAT ? SEQ : CTXL;
            const bf16_t* row = PB + (size_t)r * NPB + c8 * 8;
            const u32x4 bg = *(const u32x4*)(row + 256), c0 = *(const u32x4*)(row + 512), u0 = *(const u32x4*)(row + 768);
            u32x4 cm = (u32x4){0u, 0u, 0u, 0u}, um = cm, cp = cm, up = cm;
            if (t > 0) { cm = *(const u32x4*)(row - NPB + 512); um = *(const u32x4*)(row - NPB + 768); }
            if (t < L - 1) { cp = *(const u32x4*)(row + NPB + 512); up = *(const u32x4*)(row + NPB + 768); }
            u32x4 o;
#pragma unroll
            for (int w = 0; w < 4; ++w) {
                const int ch = c8 * 8 + 2 * w;
                const float zl0 = lo16(cm[w]) * lo16(um[w]), zl1 = hi16(cm[w]) * hi16(um[w]);
                const float zc0 = lo16(c0[w]) * lo16(u0[w]), zc1 = hi16(c0[w]) * hi16(u0[w]);
                const float zr0 = lo16(cp[w]) * lo16(up[w]), zr1 = hi16(cp[w]) * hi16(up[w]);
                const float y0 = cw[ch] * zl0 + cw[256 + ch] * zc0 + cw[512 + ch] * zr0 + cb[ch];
                const float y1 = cw[ch + 1] * zl1 + cw[256 + ch + 1] * zc1 + cw[512 + ch + 1] * zr1 + cb[ch + 1];
                o[w] = pkbf(lo16(bg[w]) * y0, hi16(bg[w]) * y1);
            }
            *(u32x4*)(YC + (size_t)r * D + 768 + c8 * 8) = o;
        }
    }
}

__device__ __forceinline__ void scan_states(const Params& p, int tix0, int tstride) {
    unsigned char* ws = wsp();
    const bf16_t* DS = (const bf16_t*)(ws + WS_H); bf16_t* S = (bf16_t*)(ws + WS_PB); const float* DEC = (const float*)(ws + WS_DEC);
    for (int tix = tix0; tix < 64 * 128 * 8; tix += tstride) {
        const int unit = tix >> 10, v = (tix >> 3) & 127, dg = tix & 7, dir = unit & 1;
        float s[8];
#pragma unroll
        for (int j = 0; j < 8; ++j) s[j] = 0.f;
#pragma unroll 4
        for (int step = 0; step < NCH; ++step) {
            const int cidx = dir == 0 ? step : (step < 4 ? 3 - step : 39 - step);
            const size_t a = ((size_t)(unit * NCH + cidx) * 128 + v) * 64 + dg * 8;
            const u32x4 dsv = *(const u32x4*)(DS + a);
            const f32x4 d0 = *(const f32x4*)(DEC + (size_t)(unit * NCH + cidx) * 64 + dg * 8), d1 = *(const f32x4*)(DEC + (size_t)(unit * NCH + cidx) * 64 + dg * 8 + 4);
            u32x4 o; o[0] = pkbf(s[0], s[1]); o[1] = pkbf(s[2], s[3]); o[2] = pkbf(s[4], s[5]); o[3] = pkbf(s[6], s[7]);
            *(u32x4*)(S + a) = o;
            s[0] = d0[0] * s[0] + lo16(dsv[0]); s[1] = d0[1] * s[1] + hi16(dsv[0]); s[2] = d0[2] * s[2] + lo16(dsv[1]); s[3] = d0[3] * s[3] + hi16(dsv[1]);
            s[4] = d1[0] * s[4] + lo16(dsv[2]); s[5] = d1[1] * s[5] + hi16(dsv[2]); s[6] = d1[2] * s[6] + lo16(dsv[3]); s[7] = d1[3] * s[7] + hi16(dsv[3]);
        }
    }
}

__device__ __forceinline__ void g3_item(const Params& p, LAS unsigned char* lds, int tid, int lane, int wave, int li, int b, int cidx, int h) {
    unsigned char* ws = wsp();
    const int row0 = cidx < 4 ? MLAT + b * CTXL + cidx * 64 : b * SEQ + (cidx - 4) * 64;
    LAS float* lr_s = (LAS float*)(lds);
    LAS float* wd_s = (LAS float*)(lds + 8192);
    LAS float* seg_s = (LAS float*)(lds + 16384);
    LAS float* gm_s = (LAS float*)(lds + 18432);
    LAS float* ssq_s = (LAS float*)(lds + 18688);
    LAS bf16_t* v_s = (LAS bf16_t*)(lds + 20736);
    LAS bf16_t* qt_s = (LAS bf16_t*)(lds + 38144);
    LAS bf16_t* kt_s = (LAS bf16_t*)(lds + 47360);
    LAS bf16_t* ao_s = (LAS bf16_t*)(lds + 56576);
    const bf16_t* PA = (const bf16_t*)(ws + WS_PA);
    const float* LR = (const float*)(ws + WS_LR);
    const bf16_t* S = (const bf16_t*)(ws + WS_PB);
    const int d = tid & 63, tg = wave, fr = lane & 15, fq = lane >> 4;
#pragma unroll
    for (int q = 0; q < 4; ++q) { const int e = tid + NTHR * q; lr_s[e] = LR[(size_t)(row0 + (e >> 5)) * 32 + (e & 31)];
        const int e1 = e & 1023; wd_s[e] = inp((e >> 10) ? 13 : 11)[li * 4096 + (e1 >> 6) * 256 + h * 64 + (e1 & 63)]; }
#pragma unroll
    for (int q = 0; q < 2; ++q) { const int e = tid + NTHR * q; const int t = e >> 4, rr = e & 15;
        *(LAS u32x4*)(v_s + t * 136 + rr * 8) = *(const u32x4*)(PA + (size_t)(row0 + t) * NPA + 256 + h * 128 + rr * 8); }
    float kk[8], qq[8];
#pragma unroll
    for (int i = 0; i < 8; ++i) { const bf16_t* rp = PA + (size_t)(row0 + 8 * tg + i) * NPA + h * 64 + d; kk[i] = bf2f(rp[0]); qq[i] = bf2f(rp[768]) * 0.125f; }
    __syncthreads();
    bf16x8 vb[2];
#pragma unroll
    for (int ks = 0; ks < 2; ++ks)
#pragma unroll
        for (int j = 0; j < 8; ++j) vb[ks][j] = (short)v_s[(32 * ks + 8 * fq + j) * 136 + 16 * wave + fr];
    f32x4 oacc[4];
#pragma unroll
    for (int i = 0; i < 4; ++i) oacc[i] = (f32x4){0.f, 0.f, 0.f, 0.f};
#pragma unroll 1
    for (int dir = 0; dir < 2; ++dir) {
        const int unit = (b * 4 + h) * 2 + dir;
        const bf16_t* Sp = S + ((size_t)(unit * NCH + cidx) * 128 + 16 * wave + fr) * 64 + 8 * fq;
        const bf16x8 sf0 = *(const bf16x8*)(Sp), sf1 = *(const bf16x8*)(Sp + 32);
        const float bd = inp(dir ? 14 : 12)[li * 256 + h * 64 + d];
        float wd[16];
#pragma unroll
        for (int r = 0; r < 16; ++r) wd[r] = wd_s[dir * 1024 + r * 64 + d];
        float c[8];
#pragma unroll
        for (int i = 0; i < 8; ++i) c[i] = logsig_z(lr_s + (8 * tg + i) * 32 + dir * 16, wd, bd);
        if (dir == 0) {
#pragma unroll
            for (int i = 1; i < 8; ++i) c[i] += c[i - 1];
        } else {
#pragma unroll
            for (int i = 6; i >= 0; --i) c[i] += c[i + 1];
        }
        seg_s[tg * 64 + d] = dir == 0 ? c[7] : c[0];
        __syncthreads();
        float off = 0.f;
#pragma unroll
        for (int g = 0; g < 8; ++g) { const float s = seg_s[g * 64 + d]; if (dir == 0 ? (g < tg) : (g > tg)) off += s; }
#pragma unroll
        for (int i = 0; i < 8; ++i) c[i] += off;
        if (dir == 0 ? (tg == 3) : (tg == 4)) gm_s[d] = dir == 0 ? c[7] : c[0];
        __syncthreads();
        const float gm = gm_s[d];
#pragma unroll
        for (int i = 0; i < 8; ++i) { const int t = 8 * tg + i;
            qt_s[t * 72 + d] = f2bf(qq[i] * __expf(c[i] - gm)); kt_s[t * 72 + d] = f2bf(kk[i] * __expf(gm - c[i])); ao_s[t * 136 + 64 + d] = f2bf(qq[i] * __expf(c[i])); }
        __syncthreads();
        {
            const int it = wave >> 1;
            const bf16x8 a0 = *(const LAS bf16x8*)(qt_s + (16 * it + fr) * 72 + 8 * fq), a1 = *(const LAS bf16x8*)(qt_s + (16 * it + fr) * 72 + 32 + 8 * fq);
#pragma unroll
            for (int jj = 0; jj < 2; ++jj) { const int jt = 2 * (wave & 1) + jj;
                const bf16x8 b0 = *(const LAS bf16x8*)(kt_s + (16 * jt + fr) * 72 + 8 * fq), b1 = *(const LAS bf16x8*)(kt_s + (16 * jt + fr) * 72 + 32 + 8 * fq);
                f32x4 acc = (f32x4){0.f, 0.f, 0.f, 0.f};
                acc = __builtin_amdgcn_mfma_f32_16x16x32_bf16(a0, b0, acc, 0, 0, 0);
                acc = __builtin_amdgcn_mfma_f32_16x16x32_bf16(a1, b1, acc, 0, 0, 0);
#pragma unroll
                for (int ii = 0; ii < 4; ++ii) { const int ir = 16 * it + 4 * fq + ii, jc = 16 * jt + fr; const bool keep = dir == 0 ? (jc <= ir) : (jc >= ir);
                    ao_s[ir * 136 + jc] = f2bf(keep ? acc[ii] : 0.f); } }
        }
        __syncthreads();
#pragma unroll
        for (int it = 0; it < 4; ++it) {
            const LAS bf16_t* ap = ao_s + (16 * it + fr) * 136 + 8 * fq;
            oacc[it] = __builtin_amdgcn_mfma_f32_16x16x32_bf16(*(const LAS bf16x8*)(ap), vb[0], oacc[it], 0, 0, 0);
            oacc[it] = __builtin_amdgcn_mfma_f32_16x16x32_bf16(*(const LAS bf16x8*)(ap + 32), vb[1], oacc[it], 0, 0, 0);
            oacc[it] = __builtin_amdgcn_mfma_f32_16x16x32_bf16(*(const LAS bf16x8*)(ap + 64), sf0, oacc[it], 0, 0, 0);
            oacc[it] = __builtin_amdgcn_mfma_f32_16x16x32_bf16(*(const LAS bf16x8*)(ap + 96), sf1, oacc[it], 0, 0, 0);
        }
        __syncthreads();
    }
#pragma unroll
    for (int it = 0; it < 4; ++it)
#pragma unroll
        for (int ii = 0; ii < 4; ++ii) { float sq = oacc[it][ii] * oacc[it][ii];
            sq += __shfl_xor(sq, 1); sq += __shfl_xor(sq, 2); sq += __shfl_xor(sq, 4); sq += __shfl_xor(sq, 8);
            if (fr == 0) ssq_s[wave * 64 + 16 * it + 4 * fq + ii] = sq; }
    __syncthreads();
    const int vcol = h * 128 + 16 * wave + fr;
    const float gn = inp(15)[li * 512 + vcol];
    bf16_t* YC = (bf16_t*)(ws + WS_YC);
#pragma unroll
    for (int it = 0; it < 4; ++it)
#pragma unroll
        for (int ii = 0; ii < 4; ++ii) { const int i = 16 * it + 4 * fq + ii; float tot = 0.f;
#pragma unroll
            for (int w = 0; w < 8; ++w) tot += ssq_s[w * 64 + i];
            const float rs = rsqrtf(tot * (1.0f / 128.0f) + EPS);
            const float rv = bf2f(PA[(size_t)(row0 + i) * NPA + 1024 + vcol]);
            YC[(size_t)(row0 + i) * D + vcol] = f2bf(((oacc[it][ii] * rs) * gn) * silu_f(rv)); }
    __syncthreads();
}


#ifndef DBG_STOP
#define DBG_STOP 99
#endif
__device__ __forceinline__ void dbg_digest() {
    const int bid = blockIdx.x, tid = threadIdx.x, G = gridDim.x;
    const unsigned* w = (const unsigned*)wsp(); unsigned* o = (unsigned*)outp();
    const size_t NW = WS_END / 4, NO = (size_t)MLAT * D;
    for (size_t i = (size_t)bid * NTHR + tid; i < NO; i += (size_t)G * NTHR) {
        unsigned x = o[i];
        for (size_t j = i; j < NW; j += NO) x ^= w[j];
        ((float*)o)[i] = (float)((x ^ (x >> 16)) & 0xFFFFu);
    }
}
#define DBG_CHECK(k) do { if (DBG_STOP == (k)) { GRID_SYNC_CG(); FRESH(); dbg_digest(); return; } } while (0)

#define RLX_AGENT __ATOMIC_RELAXED, __HIP_MEMORY_SCOPE_AGENT
#define XB_TMO      128
#define XB_XCNT(j)  (256  + 64 * (j))
#define XB_XSUB(j)  (1280 + 64 * (j))
#define XB_XGEN(j)  (2304 + 64 * (j))
#define XB_TOP      3328
#define XB_TOPGEN   3392
#define XCD_BAR_WORDS 3456
#define XB_SPIN_CAP (1u << 18)

__device__ __forceinline__ unsigned xb_ld(unsigned* p)              { return __hip_atomic_load(p, __ATOMIC_RELAXED, __HIP_MEMORY_SCOPE_AGENT); }
__device__ __forceinline__ unsigned xb_add(unsigned* p, unsigned v) { return __hip_atomic_fetch_add(p, v, __ATOMIC_RELAXED, __HIP_MEMORY_SCOPE_AGENT); }
__device__ __forceinline__ unsigned xb_xcc_id() { return (unsigned)__builtin_amdgcn_s_getreg((3 << 11) | 20) & 0xFu; }
#define XB_SPIN(cond, bar) do { unsigned _sp = 0; while (cond) { __builtin_amdgcn_s_sleep(1); \
    if ((++_sp & 255u) == 0u) { if (xb_ld(&(bar)[XB_TMO])) break; if (_sp > XB_SPIN_CAP) { atomicAdd(&(bar)[XB_TMO], 1u); break; } } } } while (0)

struct XcdBarrier {
    unsigned* bar; unsigned x;
    volatile LAS unsigned* st;
};

__device__ __forceinline__ XcdBarrier xcd_barrier_post(unsigned* bar, volatile LAS unsigned* st) {
    XcdBarrier b; b.bar = bar; b.x = xb_xcc_id(); b.st = st;
    if (threadIdx.x == 0) (void)xb_add(&bar[XB_XCNT(b.x)], 1u);
    return b;
}
__device__ __forceinline__ void xcd_barrier_complete(unsigned* bar, unsigned x, unsigned& nloc, unsigned& nx) {
    const unsigned G = gridDim.x * gridDim.y * gridDim.z;
    unsigned sum, cnt, mine, sp = 0u;
    for (;;) {
        sum = 0u; cnt = 0u; mine = 0u;
#pragma unroll
        for (unsigned j = 0; j < 16; ++j) { const unsigned c = xb_ld(&bar[XB_XCNT(j)]); sum += c; cnt += (c > 0u) ? 1u : 0u; mine = (j == x) ? c : mine; }
        if (sum == G) break;
        __builtin_amdgcn_s_sleep(1);
        if ((++sp & 255u) == 0u) { if (xb_ld(&bar[XB_TMO])) break; if (sp > XB_SPIN_CAP) { atomicAdd(&bar[XB_TMO], 1u); break; } }
    }
    nloc = mine > 0u ? mine : 1u; nx = cnt > 0u ? cnt : 1u;
}

__device__ __forceinline__ void xcd_barrier(const XcdBarrier& b) {
    asm volatile("s_waitcnt vmcnt(0)" ::: "memory");
    __syncthreads();
    if (threadIdx.x == 0) {
        unsigned* bar = b.bar;
        __builtin_amdgcn_s_waitcnt(0);
        unsigned nloc = b.st[0], nx = b.st[1];
        if (nloc == 0u) { xcd_barrier_complete(bar, b.x, nloc, nx); b.st[0] = nloc; b.st[1] = nx; }
        const unsigned old = xb_add(&bar[XB_XSUB(b.x)], 1u);
        const unsigned gen = old / nloc;
        if (old + 1u == (gen + 1u) * nloc) {
            __builtin_amdgcn_fence(__ATOMIC_RELEASE, "agent");
            asm volatile("s_waitcnt vmcnt(0)" ::: "memory");
            const unsigned og = xb_add(&bar[XB_TOP], 1u);
            const unsigned tg = og / nx;
            if (og + 1u == (tg + 1u) * nx) xb_add(&bar[XB_TOPGEN], 1u);
            else XB_SPIN(xb_ld(&bar[XB_TOPGEN]) == tg, bar);
            __builtin_amdgcn_fence(__ATOMIC_ACQUIRE, "agent");
            xb_add(&bar[XB_XGEN(b.x)], 1u);
            asm volatile("s_waitcnt vmcnt(0)" ::: "memory");
        } else {
            XB_SPIN(xb_ld(&bar[XB_XGEN(b.x)]) == gen, bar);
            __builtin_amdgcn_fence(__ATOMIC_ACQUIRE, "agent");
            asm volatile("s_waitcnt vmcnt(0)" ::: "memory");
        }
    }
    __syncthreads();
}


#ifndef REP_SYNC
#define REP_SYNC 1
#endif
#ifndef REP_GEMM
#define REP_GEMM 1
#endif
#ifndef REP_X13
#define REP_X13 1
#endif
#ifndef REP_X2
#define REP_X2 1
#endif
#ifndef REP_PRO
#define REP_PRO 1
#endif
#ifndef REP_R0
#define REP_R0 1
#endif
#define REPEAT(n) _Pragma("unroll 1") for (int rep_ = 0; rep_ < (n); ++rep_)
#define GEMM_CALL(EPI, g, S, E) REPEAT(REP_GEMM) pg8::gemm_phase<EPI, pg8::StaticOrder, true, true>(lds, g, S, E)

__global__ void __launch_bounds__(NTHR, 2) hybrid_fwd(Params p) {
    extern __shared__ __attribute__((aligned(16))) unsigned char lds_raw[];
    LAS unsigned char* lds = (LAS unsigned char*)lds_raw;
    cg::grid_group grid = cg::this_grid();
    int tid, lane, wave, bid; const int G = gridDim.x;
    unsigned char* ws; bf16_t *H, *PA, *PB, *YC;
#define FRESH() do { int t_ = threadIdx.x; asm volatile("" : "+v"(t_)); tid = t_; lane = tid & 63; wave = __builtin_amdgcn_readfirstlane(tid >> 6); int b_ = blockIdx.x; asm volatile("" : "+s"(b_)); bid = b_; \
        ws = wsp(); H = (bf16_t*)(ws + WS_H); PA = (bf16_t*)(ws + WS_PA); PB = (bf16_t*)(ws + WS_PB); YC = (bf16_t*)(ws + WS_YC); } while (0)
#define GRID_SYNC_CG() do { asm volatile("s_waitcnt vmcnt(0) lgkmcnt(0)" ::: "memory"); __builtin_amdgcn_fence(__ATOMIC_RELEASE, "agent"); grid.sync(); \
        __builtin_amdgcn_fence(__ATOMIC_ACQUIRE, "agent"); asm volatile("s_waitcnt vmcnt(0)" ::: "memory"); } while (0)
    FRESH();
    volatile LAS unsigned* bst = (volatile LAS unsigned*)(lds + LDS_BYTES - 16);
    if (tid == 0) { bst[0] = 0u; bst[1] = 0u; }
    if (bid == 0) for (int i = tid; i < XCD_BAR_WORDS; i += NTHR) ((unsigned*)ws)[i] = 0u;
    __syncthreads();
    XcdBarrier xbar; xbar.bar = (unsigned*)ws; xbar.x = 0; xbar.st = bst;
#define GRID_SYNC() REPEAT(REP_SYNC) do { xcd_barrier(xbar); } while (0)

    REPEAT(REP_PRO) phase_prologue(p, lds, tid, lane, wave, bid, G);
    DBG_CHECK(0);
    GRID_SYNC_CG(); FRESH();
    xbar = xcd_barrier_post((unsigned*)ws, bst);
    REPEAT(REP_R0) phase_rows(p, lds, tid, lane, wave, bid, G, 0, 0);
    DBG_CHECK(1);
    GRID_SYNC(); FRESH();
#pragma unroll 1
    for (int li = 0; li < 2; ++li) {
        {
            const bf16_t* W = (const bf16_t*)(ws + WS_WIN) + (size_t)li * NP * 1024;
            const int M1 = li == 0 ? MTOT : MLAT;
            pg8::Gemm g{H, W, M1, NP, 1024}; pg8::StaticOrder S; S.init(M1, NP, G, bid);
            EpiStore E{PA, NPA, PB, NPB, 6};
            GEMM_CALL(EpiStore, g, S, E);
            if (li == 1) {
                const int shift = ((MLAT / 256) * (NP / 256)) % G;
                pg8::Gemm g2{H + (size_t)MLAT * 1024, W, MCTX, 768, 1024}; pg8::StaticOrder S2; S2.init(MCTX, 768, G, (bid - shift + G) % G);
                EpiStore E2{PA + (size_t)MLAT * NPA, NPA, PB, NPB, 6};
                GEMM_CALL(EpiStore, g2, S2, E2);
            }
        }
        DBG_CHECK(2 + li * 9 + 0);
        GRID_SYNC(); FRESH();
        REPEAT(REP_X13) phase_x1(p, lds, tid, lane, wave, bid, G, li);
        DBG_CHECK(2 + li * 9 + 1);
        GRID_SYNC(); FRESH();
        {
            const int nfb = 64;
            if (bid < nfb) {
                pg8::Gemm g{(const bf16_t*)(ws + WS_DL), (const bf16_t*)(ws + WS_ZT), SEQ, NB * 256, SEQ}; pg8::StaticOrder S; S.init(SEQ, NB * 256, nfb, bid);
                EpiF2 E{YC + 512, SEQ};
                GEMM_CALL(EpiF2, g, S, E);
            } else if (li == 0 && bid < nfb + 8) {
                pg8::Gemm g{(const bf16_t*)(ws + WS_DLC), (const bf16_t*)(ws + WS_ZTC), CTXL, NB * 256, CTXL}; pg8::StaticOrder S; S.init(CTXL, NB * 256, 8, bid - nfb);
                EpiF2 E{YC + (size_t)MLAT * D + 512, CTXL};
                GEMM_CALL(EpiF2, g, S, E);
            }
            if (G == 256) {
                const int n1 = bid < nfb ? 3 : 11, i0 = bid < nfb ? 2112 + bid * 3 : (bid - nfb) * 11;
                REPEAT(REP_X13) for (int it = i0; it < i0 + n1; ++it) g1_item(p, lds, tid, lane, wave, li, it);
            } else { for (int it = bid; it < NB * NCH * 8; it += G) g1_item(p, lds, tid, lane, wave, li, it); }
        }
        GRID_SYNC(); FRESH();
        REPEAT(REP_X2) scan_states(p, bid * NTHR + tid, G * NTHR);
        DBG_CHECK(2 + li * 9 + 2);
        GRID_SYNC(); FRESH();
        REPEAT(REP_X13) if (li == 0) { for (int it = bid; it < NB * NCH * 4; it += G) { const int b = it / (NCH * 4), rem = it % (NCH * 4); g3_item(p, lds, tid, lane, wave, li, b, rem >> 2, rem & 3); } }
        else { for (int it = bid; it < NB * 32 * 4; it += G) g3_item(p, lds, tid, lane, wave, li, it >> 7, 4 + ((it >> 2) & 31), it & 3); }
        DBG_CHECK(2 + li * 9 + 3);
        GRID_SYNC(); FRESH();
        {
            const int M1 = li == 0 ? MTOT : MLAT;
            pg8::Gemm g{YC, (const bf16_t*)(ws + WS_WOUT) + (size_t)li * 1024 * 1024, M1, 1024, 1024}; pg8::StaticOrder S; S.init(M1, 1024, G, bid);
            EpiStore E{(bf16_t*)(ws + WS_Y), 1024, nullptr, 0, 1 << 20};
            GEMM_CALL(EpiStore, g, S, E);
        }
        DBG_CHECK(2 + li * 9 + 4);
        GRID_SYNC(); FRESH();
        phase_rows(p, lds, tid, lane, wave, bid, G, 1, li);
        DBG_CHECK(2 + li * 9 + 5);
        GRID_SYNC(); FRESH();
        {
            const int M1 = li == 0 ? MTOT : MLAT;
            pg8::Gemm g{H, (const bf16_t*)(ws + WS_WFI) + (size_t)li * 2 * FFH * 1024, M1, 2 * FFH, 1024}; pg8::StaticOrder S; S.init(M1, 2 * FFH, G, bid);
            EpiSwiglu E{(bf16_t*)(ws + WS_HID), FFH};
            GEMM_CALL(EpiSwiglu, g, S, E);
        }
        DBG_CHECK(2 + li * 9 + 6);
        GRID_SYNC(); FRESH();
        {
            const int M1 = li == 0 ? MTOT : MLAT;
            pg8::Gemm g{(const bf16_t*)(ws + WS_HID), (const bf16_t*)(ws + WS_WFO) + (size_t)li * 1024 * FFH, M1, 1024, FFH}; pg8::StaticOrder S; S.init(M1, 1024, G, bid);
            EpiStore E{(bf16_t*)(ws + WS_Y2), 1024, nullptr, 0, 1 << 20};
            GEMM_CALL(EpiStore, g, S, E);
        }
        DBG_CHECK(2 + li * 9 + 7);
        GRID_SYNC(); FRESH();
        phase_rows(p, lds, tid, lane, wave, bid, G, 2, li);
        DBG_CHECK(2 + li * 9 + 8);
        if (li == 0) { GRID_SYNC(); FRESH(); }
    }
}

extern "C" void kernel_launch(void* const* d_in, const int* in_sizes, int n_in, void* d_out, int out_size, void* d_ws, size_t ws_size, hipStream_t stream) {
    static int grid = 0;
    if (grid == 0) {
        if (n_in != 21 || out_size != MLAT * D || ws_size < WS_END) { fprintf(stderr, "kernel_launch: unexpected problem (n_in %d, out %d, ws %zu)\n", n_in, out_size, ws_size); grid = -1; return; }
        int dev = 0, cus = 0, per_cu = 0;
        hipGetDevice(&dev);
        hipDeviceGetAttribute(&cus, hipDeviceAttributeMultiprocessorCount, dev);
        hipFuncSetAttribute((const void*)hybrid_fwd, hipFuncAttributeMaxDynamicSharedMemorySize, LDS_BYTES);
        hipOccupancyMaxActiveBlocksPerMultiprocessor(&per_cu, (const void*)hybrid_fwd, NTHR, LDS_BYTES);
        if (per_cu < 1) per_cu = 1;
        grid = cus * 1;
        if (grid < 128) { fprintf(stderr, "kernel_launch: too few CUs (%d)\n", cus); grid = -1; return; }
    }
    if (grid < 0) return;
    Params p{};
    for (int i = 0; i < 21; ++i) p.in[i] = (const float*)d_in[i];
    p.out = (float*)d_out; p.ws = (unsigned char*)d_ws;
    void* args[] = {&p};
    hipError_t e = hipLaunchCooperativeKernel((const void*)hybrid_fwd, dim3(grid), dim3(NTHR), args, LDS_BYTES, stream);
    if (e != hipSuccess) fprintf(stderr, "cooperative launch failed: %s (grid %d)\n", hipGetErrorString(e), grid);
}
```
